# Optimizing an MI355X kernel written in HIP

```python
import math
import jax, jax.numpy as jnp
from jax import lax
import numpy as np

D_MODEL = 1024
BATCH = 2
SEQ = 16384
DEPTH = 2

HEAD_DIM = 64
GRID_W = 64
EPS = 1e-6

ATT_HEADS = 8
ATT_KV_HEADS = 2
ATT_WIDTH = ATT_HEADS * HEAD_DIM
KV_WIDTH = ATT_KV_HEADS * HEAD_DIM
Q_BLOCK = 128
ROPE_THETA = 10000.0
ROPE_AXIS_DIM = HEAD_DIM // 2

CONV_GROUPS = 4
CONV_WIDTH = CONV_GROUPS * HEAD_DIM
CONV_KERNEL = 31

SG_HEADS = 4
SG_WIDTH = SG_HEADS * HEAD_DIM
SG_CHUNK = 128

D_MIX = ATT_WIDTH + CONV_WIDTH + SG_WIDTH

IN_SPLIT_SIZES = (
    ATT_WIDTH,
    KV_WIDTH,
    KV_WIDTH,
    ATT_WIDTH,
    2 * CONV_WIDTH,
    CONV_WIDTH,
    SG_WIDTH,
    SG_WIDTH,
    SG_WIDTH,
)
D_IN = sum(IN_SPLIT_SIZES)

kernel_name = "hybrid_parallel_conv_gqa_sgu_encoder"


def _split_points():
    pts, acc = [], 0
    for s in IN_SPLIT_SIZES[:-1]:
        acc += s
        pts.append(acc)
    return pts


def rms_norm(x, g):
    xf = x.astype(jnp.float32)
    y = xf * lax.rsqrt(jnp.mean(xf * xf, axis=-1, keepdims=True) + EPS) * g.astype(jnp.float32)
    return y.astype(x.dtype)


def layer_norm(x, g, b):
    xf = x.astype(jnp.float32)
    mu = jnp.mean(xf, axis=-1, keepdims=True)
    xc = xf - mu
    var = jnp.mean(xc * xc, axis=-1, keepdims=True)
    y = xc * lax.rsqrt(var + EPS) * g.astype(jnp.float32) + b.astype(jnp.float32)
    return y.astype(x.dtype)


def rope_1d(x, pos):
    d = x.shape[-1]
    half = d // 2
    inv_freq = ROPE_THETA ** (-jnp.arange(half, dtype=jnp.float32) / half)
    ang = pos[:, None] * inv_freq[None, :]
    cos = jnp.cos(ang)[:, None, :]
    sin = jnp.sin(ang)[:, None, :]
    xf = x.astype(jnp.float32)
    x1, x2 = xf[..., :half], xf[..., half:]
    out = jnp.concatenate([x1 * cos - x2 * sin, x2 * cos + x1 * sin], axis=-1)
    return out.astype(x.dtype)


def axial_rope(x, row, col):
    return jnp.concatenate([rope_1d(x[..., :ROPE_AXIS_DIM], row),
                            rope_1d(x[..., ROPE_AXIS_DIM:], col)], axis=-1)


def attention_group(q, k, v):
    B, S = q.shape[0], q.shape[1]
    G = ATT_HEADS // ATT_KV_HEADS
    nblk = S // Q_BLOCK
    qb = q.reshape(B, nblk, Q_BLOCK, ATT_KV_HEADS, G, HEAD_DIM).transpose(1, 0, 3, 4, 2, 5)
    kt = k.transpose(0, 2, 1, 3)
    vt = v.transpose(0, 2, 1, 3)
    scale = HEAD_DIM ** -0.5

    def one_block(qi):
        s = jnp.einsum('bkgqd,bksd->bkgqs', qi, kt, preferred_element_type=jnp.float32) * scale
        p = jax.nn.softmax(s, axis=-1)
        return jnp.einsum('bkgqs,bksd->bkgqd', p.astype(vt.dtype), vt)

    o = lax.map(one_block, qb)
    return o.transpose(1, 0, 4, 2, 3, 5).reshape(B, S, ATT_WIDTH)


def conv_group(a, dw_w, dw_b, ln_g, ln_b):
    h = a[..., :CONV_WIDTH] * jax.nn.sigmoid(a[..., CONV_WIDTH:])
    pad = CONV_KERNEL // 2
    h = lax.conv_general_dilated(
        h, dw_w[:, None, :].astype(h.dtype), window_strides=(1,), padding=[(pad, pad)],
        dimension_numbers=('NWC', 'WIO', 'NWC'), feature_group_count=CONV_WIDTH) + dw_b
    h = layer_norm(h, ln_g, ln_b)
    return jax.nn.silu(h)


def spatial_gating_group(u, v, ln_g, ln_b, w_s, b_s):
    B, S = u.shape[0], u.shape[1]
    u = jax.nn.gelu(u, approximate=False)
    v = layer_norm(jax.nn.gelu(v, approximate=False), ln_g, ln_b)
    n = S // SG_CHUNK
    vc = v.reshape(B, n, SG_CHUNK, SG_HEADS, HEAD_DIM)
    mixed = jnp.einsum('hpq,bnqhd->bnphd', w_s, vc) + b_s.T[None, None, :, :, None]
    return u * mixed.reshape(B, S, SG_WIDTH)


def setup_inputs(seed: int = 0) -> dict:
    key = jax.random.key(seed)
    ks = jax.random.split(key, 16)
    f32 = jnp.float32
    x = jax.random.normal(ks[0], (BATCH, SEQ, D_MODEL), f32)
    pre_norm = 1.0 + 0.05 * jax.random.normal(ks[1], (DEPTH, D_MODEL), f32)
    post_norm = 1.0 + 0.05 * jax.random.normal(ks[2], (DEPTH, D_MODEL), f32)
    w_in = jax.random.normal(ks[3], (DEPTH, D_MODEL, D_IN), f32) * D_MODEL ** -0.5
    w_out = jax.random.normal(ks[4], (DEPTH, D_MIX, D_MODEL), f32) * D_MIX ** -0.5
    q_norm = 1.0 + 0.05 * jax.random.normal(ks[5], (DEPTH, HEAD_DIM), f32)
    k_norm = 1.0 + 0.05 * jax.random.normal(ks[6], (DEPTH, HEAD_DIM), f32)
    conv_dw = jax.random.normal(ks[7], (DEPTH, CONV_KERNEL, CONV_WIDTH), f32) * CONV_KERNEL ** -0.5
    conv_dw_b = 0.02 * jax.random.normal(ks[8], (DEPTH, CONV_WIDTH), f32)
    conv_ln_g = 1.0 + 0.05 * jax.random.normal(ks[9], (DEPTH, CONV_WIDTH), f32)
    conv_ln_b = 0.02 * jax.random.normal(ks[10], (DEPTH, CONV_WIDTH), f32)
    sg_ln_g = 1.0 + 0.05 * jax.random.normal(ks[11], (DEPTH, SG_WIDTH), f32)
    sg_ln_b = 0.02 * jax.random.normal(ks[12], (DEPTH, SG_WIDTH), f32)
    sg_w = jax.random.normal(ks[13], (DEPTH, SG_HEADS, SG_CHUNK, SG_CHUNK), f32) * SG_CHUNK ** -0.5
    sg_b = 1.0 + 0.1 * jax.random.normal(ks[14], (DEPTH, SG_HEADS, SG_CHUNK), f32)
    return {"x": x, "pre_norm": pre_norm, "post_norm": post_norm, "w_in": w_in, "w_out": w_out,
            "q_norm": q_norm, "k_norm": k_norm, "conv_dw": conv_dw, "conv_dw_b": conv_dw_b,
            "conv_ln_g": conv_ln_g, "conv_ln_b": conv_ln_b, "sg_ln_g": sg_ln_g, "sg_ln_b": sg_ln_b,
            "sg_w": sg_w, "sg_b": sg_b}


def reference(x, pre_norm, post_norm, w_in, w_out, q_norm, k_norm, conv_dw, conv_dw_b,
              conv_ln_g, conv_ln_b, sg_ln_g, sg_ln_b, sg_w, sg_b):
    B, S = x.shape[0], x.shape[1]
    rows = S // GRID_W
    row = jnp.repeat(jnp.arange(rows, dtype=jnp.int32), GRID_W).astype(jnp.float32)
    col = jnp.tile(jnp.arange(GRID_W, dtype=jnp.int32), rows).astype(jnp.float32)
    split_pts = _split_points()

    for l in range(DEPTH):
        h = rms_norm(x, pre_norm[l])
        proj = jnp.einsum('bsd,de->bse', h, w_in[l])
        q, k, v, g_att, a_conv, g_conv, u_sg, v_sg, g_sg = jnp.split(proj, split_pts, axis=-1)

        q = axial_rope(rms_norm(q.reshape(B, S, ATT_HEADS, HEAD_DIM), q_norm[l]), row, col)
        k = axial_rope(rms_norm(k.reshape(B, S, ATT_KV_HEADS, HEAD_DIM), k_norm[l]), row, col)
        v = v.reshape(B, S, ATT_KV_HEADS, HEAD_DIM)
        att = attention_group(q, k, v) * jax.nn.silu(g_att)

        cnv = conv_group(a_conv, conv_dw[l], conv_dw_b[l], conv_ln_g[l], conv_ln_b[l]) * jax.nn.silu(g_conv)

        sgu = spatial_gating_group(u_sg, v_sg, sg_ln_g[l], sg_ln_b[l], sg_w[l], sg_b[l]) * jax.nn.silu(g_sg)

        mix = jnp.einsum('bse,ed->bsd', jnp.concatenate([att, cnv, sgu], axis=-1), w_out[l])
        x = x + rms_norm(mix, post_norm[l])
    return x
```

```cpp
#include <hip/hip_runtime.h>
#include <hip/hip_cooperative_groups.h>
#include <cstdio>
#include <cstdint>
namespace cg = cooperative_groups;
#include <hip/hip_bf16.h>
#include <cmath>
namespace pg8 {
#define PG8_LAS __attribute__((address_space(3)))
typedef unsigned short bf16_t;
typedef short bf16x8 __attribute__((ext_vector_type(8)));
typedef float f32x4 __attribute__((ext_vector_type(4)));
typedef unsigned u32x4 __attribute__((ext_vector_type(4)));
constexpr int BM = 256, BK = 64, HALF = 128, HTB = HALF * BK * 2  , STAGE_BYTES = 8 * HTB, NXCD = 8, WGM = 8;

__host__ __device__ __forceinline__ int lds_byte(int r, int c) { const int st = (r >> 4) * 2 + (c >> 5), rr = r & 15, cc = c & 31, ob = rr * 64 + cc * 2; return st * 1024 + (ob ^ (((ob >> 9) & 1) << 5)); }
__host__ __device__ __forceinline__ void stage_rc(int b, int& R, int& C) { const int st = b / 1024, sb = b % 1024, swz = sb ^ (((sb >> 9) & 1) << 5); R = (st >> 1) * 16 + swz / 64; C = (st & 1) * 32 + (swz % 64) / 2; }
__host__ __device__ __forceinline__ int perm32(int rho) { const int n = rho >> 4, i = rho & 15; return 8 * (i >> 2) + 4 * n + (i & 3); }

struct Unit { int pm, pn; };
struct Gemm { const bf16_t* A; const bf16_t* Bt; int M, N, K; };

struct StaticOrder {
    int nM, nN, nwg, G, c;
    __host__ __device__ void init(int M, int N, int G_, int c_) { nM = M / BM; nN = N / BM; nwg = nM * nN; G = G_; c = c_; }
    __host__ __device__ bool next(int i, Unit& u) const {
        const long L = (long)i * G + c; if (L >= nwg) return false;
        int wgid = (int)L; { const int q = nwg / NXCD, r = nwg % NXCD, xcd = wgid % NXCD, off = wgid / NXCD; wgid = (xcd < r ? xcd * (q + 1) : r * (q + 1) + (xcd - r) * q) + off; }
        const int nig = WGM * nN, gid = wgid / nig, fm = gid * WGM, gsz = (nM - fm) < WGM ? (nM - fm) : WGM;
        u.pm = fm + ((wgid % nig) % gsz); u.pn = (wgid % nig) / gsz; return true;
    }
    __device__ __forceinline__ void a_ready(const Unit&) const {}
    __device__ __forceinline__ void done(const Unit&) const {}
};

__device__ __forceinline__ unsigned cvt_pk_bf16(float lo, float hi) { unsigned r; asm volatile("v_cvt_pk_bf16_f32 %0, %1, %2" : "=v"(r) : "v"(lo), "v"(hi)); return r; }
typedef float f32x2 __attribute__((ext_vector_type(2)));
__device__ __forceinline__ f32x2 gelu_pk(f32x2 v) {
    const f32x2 av = __builtin_elementwise_abs(v), d = av * 0.2316418882f + 1.0f;
    f32x2 t; t.x = __builtin_amdgcn_rcpf(d.x); t.y = __builtin_amdgcn_rcpf(d.y);
    f32x2 q = t * 0.5307027145f + (-0.7265760135f); q = q * t + 0.7107068705f; q = q * t + (-0.142248368f); q = q * t + 0.127414796f; q = q * t;
    const f32x2 s = (v * v) * (-0.72134752044f);
    f32x2 e; e.x = __builtin_amdgcn_exp2f(s.x); e.y = __builtin_amdgcn_exp2f(s.y);
    const f32x2 m = v * (q * e), r = v - m;
    f32x2 o; o.x = v.x < 0.f ? m.x : r.x; o.y = v.y < 0.f ? m.y : r.y; return o;
}

template <int ACT  > struct EpiBf16 {
    static constexpr bool PERM = true, AFTER_DRAIN = false; static_assert(ACT == 0 || ACT == 1, "EpiBf16: ACT is 0 (none) or 1 (gelu_pk)");
    bf16_t* O; int ldc; const float* bias; int split_cols; size_t split_stride; float scale0;
    __device__ __forceinline__ void operator()(const f32x4 (&acc)[2][2][4][2], const Unit& u, int wr, int wc, int fr, int fq) const {
        const int row0 = u.pm * BM + wr * 64 + fr; int colt = u.pn * BM; bf16_t* base = O;
        float sc = 1.f; if (split_cols) { const int t = colt / split_cols; base += (size_t)t * split_stride; colt -= t * split_cols; if (t == 0) sc = scale0; }
        const int col0 = colt + wc * 32 + 8 * fq, bcol0 = u.pn * BM + wc * 32 + 8 * fq;
        f32x4 bv[2][2];
#pragma unroll
        for (int bj = 0; bj < 2; ++bj)
#pragma unroll
            for (int n = 0; n < 2; ++n) bv[bj][n] = bias ? *(const f32x4*)(bias + bcol0 + bj * HALF + 4 * n) : (f32x4){0.f, 0.f, 0.f, 0.f};
#pragma unroll
        for (int ai = 0; ai < 2; ++ai)
#pragma unroll
            for (int m = 0; m < 4; ++m) { bf16_t* rowp = base + (size_t)(row0 + ai * HALF + m * 16) * ldc + col0;
#pragma unroll
                for (int bj = 0; bj < 2; ++bj) { f32x4 v0 = acc[ai][bj][m][0] + bv[bj][0], v1 = acc[ai][bj][m][1] + bv[bj][1];
                    if (ACT == 1) { f32x2 a = gelu_pk((f32x2){v0[0], v0[1]}), b = gelu_pk((f32x2){v0[2], v0[3]}), c = gelu_pk((f32x2){v1[0], v1[1]}), d = gelu_pk((f32x2){v1[2], v1[3]});
                        v0 = (f32x4){a.x, a.y, b.x, b.y}; v1 = (f32x4){c.x, c.y, d.x, d.y}; }
                    v0 = v0 * sc; v1 = v1 * sc; u32x4 w; w.x = cvt_pk_bf16(v0[0], v0[1]); w.y = cvt_pk_bf16(v0[2], v0[3]); w.z = cvt_pk_bf16(v1[0], v1[1]); w.w = cvt_pk_bf16(v1[2], v1[3]);
                    *(u32x4*)(rowp + bj * HALF) = w; } }
    }
};
struct EpiProj {
    static constexpr bool PERM = true, AFTER_DRAIN = false;
    bf16_t* Q; bf16_t* KV; bf16_t* R;
    __device__ __forceinline__ void operator()(const f32x4 (&acc)[2][2][4][2], const Unit& u, int wr, int wc, int fr, int fq) const {
        bf16_t* base; int ldc, colt;
        if (u.pn < 2) { base = Q; ldc = 512; colt = u.pn * 256; } else if (u.pn == 2) { base = KV; ldc = 256; colt = 0; } else { base = R; ldc = 2048; colt = (u.pn - 3) * 256; }
        const int row0 = u.pm * BM + wr * 64 + fr; const int col0 = colt + wc * 32 + 8 * fq;
#pragma unroll
        for (int ai = 0; ai < 2; ++ai)
#pragma unroll
            for (int m = 0; m < 4; ++m) { bf16_t* rowp = base + (size_t)(row0 + ai * HALF + m * 16) * ldc + col0;
#pragma unroll
                for (int bj = 0; bj < 2; ++bj) { const f32x4 v0 = acc[ai][bj][m][0], v1 = acc[ai][bj][m][1];
                    u32x4 w; w.x = cvt_pk_bf16(v0[0], v0[1]); w.y = cvt_pk_bf16(v0[2], v0[3]); w.z = cvt_pk_bf16(v1[0], v1[1]); w.w = cvt_pk_bf16(v1[2], v1[3]);
                    *(u32x4*)(rowp + bj * HALF) = w; } }
    }
};
template <class Epi, class Sched, bool ALIGN_EPI = false, bool SP2 = false>
__device__ __forceinline__ void gemm_phase(PG8_LAS unsigned char* lds, const Gemm g, const Sched& S, const Epi& E) {
    int tid_l = threadIdx.x; asm volatile("" : "+v"(tid_l));
    const int tid = tid_l, wid = __builtin_amdgcn_readfirstlane(tid >> 6), lane = tid & 63, wr = wid >> 2, wc = wid & 3, fr = lane & 15, fq = lane >> 4;
    const int K = g.K, nt = K / BK;
    unsigned voffA[2], voffB[2];
#pragma unroll
    for (int i = 0; i < 2; ++i) { int R, C; stage_rc(tid * 16 + i * 8192, R, C); const int Rb = Epi::PERM ? ((R & ~31) + perm32(R & 31)) : R;
        voffA[i] = (unsigned)(R * K + C) * 2u; voffB[i] = (unsigned)(Rb * K + C) * 2u; }
    const size_t kstep = (size_t)(BK * 2);
    const size_t hstep = (size_t)HALF * K * 2;
    const size_t tstep = 2 * hstep;
    const unsigned ldsw = (unsigned)wid * 1024u;
    const int aoff = lds_byte(wr * 64 + fr, fq * 8), boff = lds_byte(wc * 32 + fr, fq * 8);
#define PG8_SA(b, h) (((b) * 2 + (h)) * HTB)
#define PG8_SB(b, h) ((4 + (b) * 2 + (h)) * HTB)
#define PG8_STAGE(bufoff, gbase, voff) do { _Pragma("unroll") for (int _i = 0; _i < 2; ++_i) \
        __builtin_amdgcn_global_load_lds((const unsigned*)((const char*)(gbase) + (voff)[_i]), (PG8_LAS unsigned*)(lds + (bufoff) + ldsw + _i * 8192), 16, 0, 0); } while (0)
#define PG8_LDA(dst, b, h) do { _Pragma("unroll") for (int m = 0; m < 4; ++m) _Pragma("unroll") for (int k = 0; k < 2; ++k) dst[m][k] = *(const PG8_LAS bf16x8*)(lds + PG8_SA(b, h) + aoff + m * 2048 + k * 1024); } while (0)
#define PG8_LDB(dst, b, h) do { _Pragma("unroll") for (int n = 0; n < 2; ++n) _Pragma("unroll") for (int k = 0; k < 2; ++k) dst[n][k] = *(const PG8_LAS bf16x8*)(lds + PG8_SB(b, h) + boff + n * 2048 + k * 1024); } while (0)
#define PG8_MMA(ai, bj, At, Bt) do { __builtin_amdgcn_s_setprio(1); _Pragma("unroll") for (int m = 0; m < 4; ++m) _Pragma("unroll") for (int n = 0; n < 2; ++n) _Pragma("unroll") for (int k = 0; k < 2; ++k) \
        acc[ai][bj][m][n] = __builtin_amdgcn_mfma_f32_16x16x32_bf16(Bt[n][k], At[m][k], acc[ai][bj][m][n], 0, 0, 0); __builtin_amdgcn_s_setprio(0); } while (0)
#define PG8_WAIT_V(n) asm volatile("s_waitcnt vmcnt(" #n ")" ::: "memory")
#define PG8_WAIT_L(n) asm volatile("s_waitcnt lgkmcnt(" #n ")" ::: "memory")
#define PG8_BAR __builtin_amdgcn_s_barrier()
#define PG8_SCHED __builtin_amdgcn_sched_barrier(0)
    Unit cur, nxt; int ui = 0;
    if (!S.next(0, cur)) return;
    f32x4 acc[2][2][4][2];
#pragma unroll
    for (int a = 0; a < 2; ++a)
#pragma unroll
        for (int b = 0; b < 2; ++b)
#pragma unroll
            for (int m = 0; m < 4; ++m)
#pragma unroll
                for (int n = 0; n < 2; ++n) acc[a][b][m][n] = (f32x4){0.f, 0.f, 0.f, 0.f};
    bf16x8 At[4][2], B0[2][2], B1[2][2];
    const char* cA = (const char*)g.A + (size_t)cur.pm * tstep; const char* cB = (const char*)g.Bt + (size_t)cur.pn * tstep;
    S.a_ready(cur);
    if constexpr (SP2) {
        PG8_STAGE(PG8_SB(0, 0), cB, voffB); PG8_STAGE(PG8_SB(0, 1), cB + hstep, voffB); PG8_STAGE(PG8_SA(0, 0), cA, voffA); PG8_STAGE(PG8_SA(0, 1), cA + hstep, voffA);
        if (wr == 1) PG8_BAR;
        PG8_WAIT_V(2); PG8_BAR;
        PG8_STAGE(PG8_SB(1, 0), cB + kstep, voffB); PG8_STAGE(PG8_SA(1, 0), cA + kstep, voffA); PG8_STAGE(PG8_SB(1, 1), cB + hstep + kstep, voffB);
        PG8_WAIT_V(6); PG8_BAR;
    } else {
        PG8_STAGE(PG8_SB(0, 0), cB, voffB); PG8_STAGE(PG8_SA(0, 0), cA, voffA); PG8_STAGE(PG8_SB(0, 1), cB + hstep, voffB); PG8_STAGE(PG8_SA(0, 1), cA + hstep, voffA);
        if (wr == 1) PG8_BAR;
        PG8_WAIT_V(4); PG8_BAR;
        PG8_STAGE(PG8_SB(1, 0), cB + kstep, voffB); PG8_STAGE(PG8_SA(1, 0), cA + kstep, voffA); PG8_STAGE(PG8_SB(1, 1), cB + hstep + kstep, voffB);
        PG8_WAIT_V(6); PG8_BAR;
    }
    for (;;) {
        const bool has_next = S.next(ui + 1, nxt);
        const char* nA = has_next ? (const char*)g.A + (size_t)nxt.pm * tstep : cA; const char* nB = has_next ? (const char*)g.Bt + (size_t)nxt.pn * tstep : cB;
        for (int t = 0; t < nt; t += 2) {
            const bool last = (t == nt - 2);
            const char* a1 = cA + (size_t)(t + 1) * kstep;
            const char* a2 = last ? nA : cA + (size_t)(t + 2) * kstep; const char* b2 = last ? nB : cB + (size_t)(t + 2) * kstep;
            const char* a3 = a2 + kstep; const char* b3 = b2 + kstep;
            if (last && has_next) S.a_ready(nxt);
            if constexpr (SP2) {
            PG8_LDB(B0, 0, 0); PG8_LDB(B1, 0, 1); PG8_SCHED; PG8_LDA(At, 0, 0); PG8_STAGE(PG8_SA(1, 1), a1 + hstep, voffA);
            PG8_WAIT_V(8); PG8_WAIT_L(0); PG8_BAR; PG8_MMA(0, 0, At, B0); PG8_MMA(0, 1, At, B1); PG8_BAR; PG8_SCHED;
            PG8_LDA(At, 0, 1); PG8_STAGE(PG8_SB(0, 0), b2, voffB); PG8_STAGE(PG8_SB(0, 1), b2 + hstep, voffB); PG8_STAGE(PG8_SA(0, 0), a2, voffA);
            PG8_WAIT_V(8); PG8_WAIT_L(0); PG8_BAR; PG8_MMA(1, 0, At, B0); PG8_MMA(1, 1, At, B1); PG8_BAR; PG8_SCHED;
            PG8_LDB(B0, 1, 0); PG8_LDB(B1, 1, 1); PG8_SCHED; PG8_LDA(At, 1, 0); PG8_STAGE(PG8_SA(0, 1), a2 + hstep, voffA);
            PG8_WAIT_V(8); PG8_WAIT_L(0); PG8_BAR; PG8_MMA(0, 0, At, B0); PG8_MMA(0, 1, At, B1); PG8_BAR; PG8_SCHED;
            PG8_LDA(At, 1, 1); PG8_STAGE(PG8_SB(1, 0), b3, voffB); PG8_STAGE(PG8_SB(1, 1), b3 + hstep, voffB); PG8_STAGE(PG8_SA(1, 0), a3, voffA);
            PG8_WAIT_V(8); PG8_WAIT_L(0); PG8_BAR; PG8_MMA(1, 0, At, B0); PG8_MMA(1, 1, At, B1); PG8_BAR; PG8_SCHED;
            } else {
            PG8_LDB(B0, 0, 0); PG8_SCHED; PG8_LDA(At, 0, 0); PG8_STAGE(PG8_SA(1, 1), a1 + hstep, voffA);
            PG8_WAIT_L(8); PG8_BAR; PG8_WAIT_L(0); PG8_MMA(0, 0, At, B0); PG8_BAR; PG8_SCHED;
            PG8_LDB(B1, 0, 1); PG8_STAGE(PG8_SB(0, 0), b2, voffB);
            PG8_BAR; PG8_WAIT_L(0); PG8_MMA(0, 1, At, B1); PG8_BAR;
            PG8_LDA(At, 0, 1); PG8_STAGE(PG8_SA(0, 0), a2, voffA);
            PG8_BAR; PG8_WAIT_L(0); PG8_MMA(1, 0, At, B0); PG8_BAR; PG8_SCHED;
            PG8_STAGE(PG8_SB(0, 1), b2 + hstep, voffB);
            PG8_WAIT_V(6); PG8_BAR; PG8_MMA(1, 1, At, B1); PG8_BAR;
            PG8_LDB(B0, 1, 0); PG8_SCHED; PG8_LDA(At, 1, 0); PG8_STAGE(PG8_SA(0, 1), a2 + hstep, voffA);
            PG8_WAIT_L(8); PG8_BAR; PG8_WAIT_L(0); PG8_MMA(0, 0, At, B0); PG8_BAR; PG8_SCHED;
            PG8_LDB(B1, 1, 1); PG8_STAGE(PG8_SB(1, 0), b3, voffB);
            PG8_BAR; PG8_WAIT_L(0); PG8_MMA(0, 1, At, B1); PG8_BAR;
            PG8_LDA(At, 1, 1); PG8_STAGE(PG8_SA(1, 0), a3, voffA);
            PG8_BAR; PG8_WAIT_L(0); PG8_MMA(1, 0, At, B0); PG8_BAR; PG8_SCHED;
            PG8_STAGE(PG8_SB(1, 1), b3 + hstep, voffB);
            PG8_WAIT_V(6); PG8_BAR; PG8_MMA(1, 1, At, B1); PG8_BAR;
            }
        }
        if constexpr (ALIGN_EPI) { if (wr == 0) PG8_BAR; }
        if constexpr (!Epi::AFTER_DRAIN) { E(acc, cur, wr, wc, fr, fq); S.done(cur); }
        if (!has_next) break;
#pragma unroll
        for (int a = 0; a < 2; ++a)
#pragma unroll
            for (int b = 0; b < 2; ++b)
#pragma unroll
                for (int m = 0; m < 4; ++m)
#pragma unroll
                    for (int n = 0; n < 2; ++n) acc[a][b][m][n] = (f32x4){0.f, 0.f, 0.f, 0.f};
        cur = nxt; cA = nA; cB = nB; ++ui;
        if constexpr (ALIGN_EPI) { if (wr == 1) PG8_BAR; }
    }
    PG8_WAIT_V(0);
    if constexpr (!ALIGN_EPI) { if (wr == 0) PG8_BAR; }
    PG8_BAR;
    if constexpr (Epi::AFTER_DRAIN) { E.fused(acc, cur, wr, wc, fr, fq, lds, wid, lane); S.done(cur); }
#undef PG8_SA
#undef PG8_SB
#undef PG8_STAGE
#undef PG8_LDA
#undef PG8_LDB
#undef PG8_MMA
#undef PG8_WAIT_V
#undef PG8_WAIT_L
#undef PG8_BAR
#undef PG8_SCHED
}
}

#ifndef PG8_SP2
#define PG8_SP2 true
#endif
#ifndef PG8_ALIGN
#define PG8_ALIGN true
#endif
namespace attn_body {
using bf16=__hip_bfloat16;
using bf16x8=__attribute__((ext_vector_type(8)))short;
using s16x4=__attribute__((ext_vector_type(4)))short;
using f32x16=__attribute__((ext_vector_type(16)))float;
using u32x4=__attribute__((ext_vector_type(4)))unsigned;
constexpr int BATCH=2,NHEAD=8,NKV=2,SEQ=16384,D=64,QP=512,KP=256,OP=1024,GP=2048;
constexpr int NW=8,QBLK=32,QB=QBLK*NW,KVBLK=64,NQB=SEQ/QB;
constexpr int ATTN_UNIT_ROWS=QB;
__device__ __forceinline__ int crow(int r,int hi){return (r&3)+8*(r>>2)+4*hi;}
#define SBAR() __builtin_amdgcn_sched_barrier(0)
__device__ __forceinline__ void cmask(f32x16&p0,f32x16&p1,int jb,int qrel,int hi){
  const float NEG=-INFINITY; int kb=64*jb+4*hi;
  #pragma unroll
  for(int r=0;r<16;++r){int kv=kb+(r&3)+8*(r>>2); if(kv>qrel)p0[r]=NEG; if(kv+32>qrel)p1[r]=NEG;}
}

constexpr int NSLOT=3, SLOTB=8192;
constexpr int LDS_K=0, LDS_V=NSLOT*SLOTB, LDS_WS=2*NSLOT*SLOTB, LDS_OST=LDS_WS+NW*64*4, LDS_BYTES=LDS_OST+NW*4096;
constexpr float C2=0.125f*1.4426950408889634f;
__device__ __forceinline__ void glds16(const void*gsrc,unsigned lds_dst){unsigned keep;
  asm volatile("s_mov_b32 %0, m0\n\ts_mov_b32 m0, %2\n\ts_nop 0\n\tglobal_load_lds_dwordx4 %1, off\n\ts_mov_b32 m0, %0":"=&s"(keep):"v"(gsrc),"s"(lds_dst):"memory");}
__device__ __forceinline__ float max3f(float a,float b,float c){float r;asm("v_max3_f32 %0, %1, %2, %3":"=v"(r):"v"(a),"v"(b),"v"(c));return r;}
__device__ __forceinline__ float max2f(float a,float b){float r;asm("v_max_f32_e32 %0, %1, %2":"=v"(r):"v"(a),"v"(b));return r;}
__device__ __forceinline__ float fadd_s(float a,float b){float r;asm("v_add_f32_e32 %0, %1, %2":"=v"(r):"v"(a),"v"(b));return r;}
__device__ __forceinline__ float fsub_s(float a,float b){float r;asm("v_sub_f32_e32 %0, %1, %2":"=v"(r):"v"(a),"v"(b));return r;}
typedef float f32x2_t __attribute__((ext_vector_type(2))); typedef __bf16 bf16x2_t __attribute__((ext_vector_type(2)));
__device__ __forceinline__ unsigned cvtpk_s(float lo,float hi){f32x2_t v={lo,hi};bf16x2_t b=__builtin_convertvector(v,bf16x2_t);return __builtin_bit_cast(unsigned,b);}
#define WAIT_BAR(N) asm volatile("s_waitcnt vmcnt(" #N ") lgkmcnt(0)\n\ts_barrier":::"memory")

__device__ __forceinline__ void qkt(f32x16&p0,f32x16&p1,const char*Kslot,const bf16x8*qr,const f32x16&negm,int r32,int hi){
  const char*kb=Kslot+hi*1024+r32*16;
  #pragma unroll
  for(int d0=0;d0<4;++d0){
    const bf16x8 b0=*reinterpret_cast<const bf16x8*>(kb+d0*2048);
    const bf16x8 b1=*reinterpret_cast<const bf16x8*>(kb+d0*2048+512);
    if(d0==0){p0=__builtin_amdgcn_mfma_f32_32x32x16_bf16(b0,qr[0],negm,0,0,0);p1=__builtin_amdgcn_mfma_f32_32x32x16_bf16(b1,qr[0],negm,0,0,0);}
    else{p0=__builtin_amdgcn_mfma_f32_32x32x16_bf16(b0,qr[d0],p0,0,0,0);p1=__builtin_amdgcn_mfma_f32_32x32x16_bf16(b1,qr[d0],p1,0,0,0);}}
}
typedef __attribute__((address_space(3))) const char* lds_cptr;
typedef short v4i16_t __attribute__((ext_vector_type(4)));
__device__ __forceinline__ void kload8(bf16x8*kf,lds_cptr kp){
  kf[0]=*(const __attribute__((address_space(3))) bf16x8*)(kp);      kf[1]=*(const __attribute__((address_space(3))) bf16x8*)(kp+512);
  kf[2]=*(const __attribute__((address_space(3))) bf16x8*)(kp+2048); kf[3]=*(const __attribute__((address_space(3))) bf16x8*)(kp+2560);
  kf[4]=*(const __attribute__((address_space(3))) bf16x8*)(kp+4096); kf[5]=*(const __attribute__((address_space(3))) bf16x8*)(kp+4608);
  kf[6]=*(const __attribute__((address_space(3))) bf16x8*)(kp+6144); kf[7]=*(const __attribute__((address_space(3))) bf16x8*)(kp+6656);
}
__device__ __forceinline__ void kload2(bf16x8*kf,lds_cptr kp,int j){ kf[2*j]=*(const __attribute__((address_space(3))) bf16x8*)(kp+j*2048); kf[2*j+1]=*(const __attribute__((address_space(3))) bf16x8*)(kp+j*2048+512); }
__device__ __forceinline__ s16x4 vtr(lds_cptr p){ return __builtin_bit_cast(s16x4,__builtin_amdgcn_ds_read_tr16_b64_v4i16((__attribute__((address_space(3))) v4i16_t*)p)); }
__device__ __forceinline__ float rowmax(const f32x16&p0,const f32x16&p1){
  float a=max3f(p0[0],p0[1],p1[0]),b=max3f(p0[2],p0[3],p1[1]);a=max3f(a,p1[2],p1[3]);
  #pragma unroll
  for(int r=4;r<16;r+=4){a=max3f(a,p0[r],p0[r+1]);b=max3f(b,p0[r+2],p0[r+3]);a=max3f(a,p1[r],p1[r+1]);b=max3f(b,p1[r+2],p1[r+3]);}
  const float m=max2f(a,b);
  auto rr=__builtin_amdgcn_permlane32_swap(__float_as_uint(m),__float_as_uint(m),false,false);
  return max2f(__uint_as_float(rr[0]),__uint_as_float(rr[1]));
}
__device__ __forceinline__ void pv(f32x16*o,int vb,bf16x8 pa0,bf16x8 pa1,bf16x8 pa2,bf16x8 pa3){
  #pragma unroll
  for(int d0=0;d0<2;++d0){s16x4 lo[4],hi[4];
    #pragma unroll
    for(int ks=0;ks<4;++ks){
      asm volatile("ds_read_b64_tr_b16 %0,%1 offset:%c2":"=&v"(lo[ks]):"v"(vb),"i"(d0*4096+ks*1024):"memory");
      asm volatile("ds_read_b64_tr_b16 %0,%1 offset:%c2":"=&v"(hi[ks]):"v"(vb),"i"(d0*4096+ks*1024+512):"memory");}
    asm volatile("s_waitcnt lgkmcnt(0)":::"memory");SBAR();
    #define PK(k) (bf16x8){lo[k][0],lo[k][1],lo[k][2],lo[k][3],hi[k][0],hi[k][1],hi[k][2],hi[k][3]}
    o[d0]=__builtin_amdgcn_mfma_f32_32x32x16_bf16(pa0,PK(0),o[d0],0,0,0);
    o[d0]=__builtin_amdgcn_mfma_f32_32x32x16_bf16(pa1,PK(1),o[d0],0,0,0);
    o[d0]=__builtin_amdgcn_mfma_f32_32x32x16_bf16(pa2,PK(2),o[d0],0,0,0);
    o[d0]=__builtin_amdgcn_mfma_f32_32x32x16_bf16(pa3,PK(3),o[d0],0,0,0);
    #undef PK
  }
}

#ifndef ATTN_STORE16
#define ATTN_STORE16(p,v) (*(u32x4*)(p)=(v))
#endif
template<int THRL> __device__ __forceinline__ void attn_unit(int b,int h,int qb,const bf16*Q,const bf16*__restrict__ K,const bf16*__restrict__ V,bf16*O,const bf16*__restrict__ G,float cshift,char*shm){
  int tid_l=threadIdx.x; asm volatile("":"+v"(tid_l)); const int tid=tid_l,lane=tid&63,r32=lane&31,hi=lane>>5; const int wid=__builtin_amdgcn_readfirstlane(tid>>6);
  const long rowbase=(long)b*SEQ; const int q0=qb*QB;
  const bf16*Qw=Q+(rowbase+q0+wid*QBLK)*QP+h*D; const int kvh=h/(NHEAD/NKV);
  const bf16*Kh=K+rowbase*KP+kvh*D,*Vh=V+rowbase*KP+kvh*D;
  const unsigned lds0=(unsigned)(uintptr_t)shm;
  float*wsf=(float*)(shm+LDS_WS)+wid*64;
  const bf16*ksrc=Kh+(long)lane*KP+wid*8;
  const bf16*vsrc=Vh+(long)(16*(wid&3)+(lane>>2))*KP+(wid>>2)*32+(lane&3)*8;
  const unsigned kdst=lds0+LDS_K+wid*1024, vdst=lds0+LDS_V+wid*1024;
  #define DMA_K(t,slot) glds16(ksrc+(long)(t)*KVBLK*KP,(unsigned)__builtin_amdgcn_readfirstlane(kdst+(slot)))
  #define DMA_V(t,slot) glds16(vsrc+(long)(t)*KVBLK*KP,(unsigned)__builtin_amdgcn_readfirstlane(vdst+(slot)))
  const int vb0=(int)(lds0+LDS_V)+((lane>>4)&1)*32+(lane&3)*8+(4*hi+((lane&15)>>2))*64;
  const char*Kbase=shm+LDS_K; bf16x8 kf[8];
  const lds_cptr shm3=(lds_cptr)shm; const lds_cptr kp0=shm3+LDS_K+hi*1024+r32*16; const lds_cptr vp0=shm3+LDS_V+((lane>>4)&1)*32+(lane&3)*8+(4*hi+((lane&15)>>2))*64;
  const int NT=SEQ/KVBLK;
  DMA_K(0,0);DMA_V(0,0);DMA_K(1,SLOTB);
  bf16x8 qr[4];
  #pragma unroll
  for(int d0=0;d0<4;++d0)qr[d0]=*reinterpret_cast<const bf16x8*>(&Qw[(long)r32*QP+d0*16+hi*8]);
  float l_reg=0.f;f32x16 o[2];o[0]=f32x16{};o[1]=f32x16{};f32x16 negm;
  _Pragma("unroll") for(int r=0;r<16;++r)negm[r]=-cshift;
  asm volatile("":"+v"(negm));
  const int qrel=wid*QBLK+r32;
  #define CMASK(P0,P1,t) do{}while(0)
  bool resc=false;
  #define START(P0,P1) do{ const float rm=rowmax(P0,P1); resc=false; \
    { const float dl=rm; mhat=fadd_s(mhat,dl); \
      _Pragma("unroll") for(int r=0;r<16;++r){P0[r]=fsub_s(P0[r],dl);P1[r]=fsub_s(P1[r],dl);} \
      _Pragma("unroll") for(int r=0;r<16;++r)negm[r]=-mhat; asm volatile("":"+v"(negm)); } \
    _Pragma("unroll") for(int r=0;r<16;++r)P0[r]=__builtin_amdgcn_exp2f(P0[r]); }while(0)
  #define RESC() do{ if(resc){ asm volatile("s_waitcnt lgkmcnt(0)":::"memory"); \
      _Pragma("unroll") for(int d_=0;d_<2;++d_) _Pragma("unroll") for(int r=0;r<16;++r)o[d_][r]*=wsf[crow(r,hi)]; } }while(0)
  f32x16 pA0,pA1,pB0,pB1;
  __builtin_amdgcn_s_setprio(1);
  int sl_prev=0,sl_cur=0,sl_next=SLOTB;
  #define ROT() do{sl_prev=sl_cur;sl_cur=sl_next;sl_next=(sl_next==(NSLOT-1)*SLOTB)?0:sl_next+SLOTB;}while(0)
  DMA_K(2,2*SLOTB);
  WAIT_BAR(3);
  qkt(pA0,pA1,Kbase,qr,negm,r32,hi);asm volatile("s_nop 15\n\ts_nop 7":"+v"(pA0),"+v"(pA1));CMASK(pA0,pA1,0);
  _Pragma("unroll") for(int r=0;r<16;++r)pA0[r]=__builtin_amdgcn_exp2f(pA0[r]);
  _Pragma("unroll") for(int r=0;r<16;++r)pA1[r]=__builtin_amdgcn_exp2f(pA1[r]);
  WAIT_BAR(0);
  DMA_K(3,0);DMA_V(1,SLOTB);
  ROT();
  kload8(kf,kp0+sl_cur);
  WAIT_BAR(2);
  s16x4 vlo[8],vhi[8]; u32x4 pw0,pw1,pw2,pw3;
  #define PKW(P,B) cvtpk_s(P[B],P[B+1])
  #define PAF(k) __builtin_bit_cast(bf16x8,pw##k)
  #define VFR(i) (bf16x8){vlo[i][0],vlo[i][1],vlo[i][2],vlo[i][3],vhi[i][0],vhi[i][1],vhi[i][2],vhi[i][3]}
  #define PIN(x) asm volatile("":"+v"(x))
  #define MX3(a,b,c) __builtin_fmaxf(__builtin_fmaxf((a),(b)),(c))
  #define GAPA(MF,A0,A1,A2,A3,W0,W1,PW) do{ __builtin_amdgcn_s_setprio(2); MF; __builtin_amdgcn_s_setprio(1); sacc+=A0; sacc+=A1; sacc+=A2; sacc+=A3; PIN(sacc); W0; W1; PIN(PW); SBAR(); }while(0)
  #define EX(v) __builtin_amdgcn_exp2f(v)
  #define GAPB(MF,X,B) do{ __builtin_amdgcn_s_setprio(0); MF; __builtin_amdgcn_s_setprio(1); X[B]=EX(X[B]); X[B+1]=EX(X[B+1]); X[B+2]=EX(X[B+2]); X[B+3]=EX(X[B+3]); PIN(X); SBAR(); }while(0)
  #define VRD(i) do{ vlo[i]=vtr(vp_+(((i)>>2)*4096+((i)&3)*1024)); vhi[i]=vtr(vp_+(((i)>>2)*4096+((i)&3)*1024+512)); }while(0)
  #define KRD(G,j) do{ if(G){ kload2(kf,kp0+sl_next,j); SBAR(); } }while(0)
  #define STEP(C0,C1,P0,P1,t,GK,GV,GL) do{ SBAR(); \
    const lds_cptr vp_=vp0+sl_prev; \
    VRD(0); SBAR(); float sacc=(P0[0]+P0[1]); \
    GAPA(C0=__builtin_amdgcn_mfma_f32_32x32x16_bf16(kf[0],qr[0],negm,0,0,0), P0[2],P0[3],P0[4],P0[5],     pw0[0]=PKW(P0,0), pw0[1]=PKW(P0,2), pw0); \
    VRD(4); SBAR(); GAPA(C1=__builtin_amdgcn_mfma_f32_32x32x16_bf16(kf[1],qr[0],negm,0,0,0), P0[6],P0[7],P0[8],P0[9],     pw0[2]=PKW(P0,4), pw0[3]=PKW(P0,6), pw0); \
    VRD(1); SBAR(); GAPA(C0=__builtin_amdgcn_mfma_f32_32x32x16_bf16(kf[2],qr[1],C0,0,0,0),   P0[10],P0[11],P0[12],P0[13], pw1[0]=PKW(P0,8), pw1[1]=PKW(P0,10), pw1); \
    VRD(5); SBAR(); GAPA(C1=__builtin_amdgcn_mfma_f32_32x32x16_bf16(kf[3],qr[1],C1,0,0,0),   P0[14],P0[15],P1[0],P1[1],   pw1[2]=PKW(P0,12),pw1[3]=PKW(P0,14), pw1); \
    VRD(2); SBAR(); GAPA(C0=__builtin_amdgcn_mfma_f32_32x32x16_bf16(kf[4],qr[2],C0,0,0,0),   P1[2],P1[3],P1[4],P1[5],     pw2[0]=PKW(P1,0), pw2[1]=PKW(P1,2), pw2); \
    VRD(6); SBAR(); GAPA(C1=__builtin_amdgcn_mfma_f32_32x32x16_bf16(kf[5],qr[2],C1,0,0,0),   P1[6],P1[7],P1[8],P1[9],     pw2[2]=PKW(P1,4), pw2[3]=PKW(P1,6), pw2); \
    VRD(3); SBAR(); GAPA(C0=__builtin_amdgcn_mfma_f32_32x32x16_bf16(kf[6],qr[3],C0,0,0,0),   P1[10],P1[11],P1[12],P1[13], pw3[0]=PKW(P1,8), pw3[1]=PKW(P1,10), pw3); \
    VRD(7); SBAR(); GAPA(C1=__builtin_amdgcn_mfma_f32_32x32x16_bf16(kf[7],qr[3],C1,0,0,0),   P1[14],P1[15],0.f,0.f,       pw3[2]=PKW(P1,12),pw3[3]=PKW(P1,14), pw3); \
    l_reg+=sacc; \
    if(GK){DMA_K((t)+3,sl_cur);} if(GV){DMA_V((t)+1,sl_next);} \
    SBAR(); \
    GAPB(o[0]=__builtin_amdgcn_mfma_f32_32x32x16_bf16(PAF(0),VFR(0),o[0],0,0,0), C0,0); \
    GAPB(o[1]=__builtin_amdgcn_mfma_f32_32x32x16_bf16(PAF(0),VFR(4),o[1],0,0,0), C0,4); \
    KRD(GL,0); GAPB(o[0]=__builtin_amdgcn_mfma_f32_32x32x16_bf16(PAF(1),VFR(1),o[0],0,0,0), C0,8); \
    KRD(GL,1); GAPB(o[1]=__builtin_amdgcn_mfma_f32_32x32x16_bf16(PAF(1),VFR(5),o[1],0,0,0), C0,12); \
    KRD(GL,2); GAPB(o[0]=__builtin_amdgcn_mfma_f32_32x32x16_bf16(PAF(2),VFR(2),o[0],0,0,0), C1,0); \
    KRD(GL,3); GAPB(o[1]=__builtin_amdgcn_mfma_f32_32x32x16_bf16(PAF(2),VFR(6),o[1],0,0,0), C1,4); \
    GAPB(o[0]=__builtin_amdgcn_mfma_f32_32x32x16_bf16(PAF(3),VFR(3),o[0],0,0,0), C1,8); \
    GAPB(o[1]=__builtin_amdgcn_mfma_f32_32x32x16_bf16(PAF(3),VFR(7),o[1],0,0,0), C1,12); \
    }while(0)
  int t=1;
  #undef CMASK
  #define CMASK(P0,P1,t) do{}while(0)
  for(;t+5<NT;t+=2){
    STEP(pB0,pB1,pA0,pA1,t,true,true,true);     WAIT_BAR(2); ROT();
    STEP(pA0,pA1,pB0,pB1,t+1,true,true,true);   WAIT_BAR(2); ROT();
  }
  #undef CMASK
  #define CMASK(P0,P1,t) do{}while(0)
  #define ENDW(tt) do{ if((tt)+3<NT){WAIT_BAR(2);} else if((tt)+2<NT){WAIT_BAR(1);} else {WAIT_BAR(0);} }while(0)
  for(;t+1<NT;t+=2){
    STEP(pB0,pB1,pA0,pA1,t,(t+3<NT),(t+1<NT),(t+1<NT));       ENDW(t);   ROT();
    STEP(pA0,pA1,pB0,pB1,t+1,(t+4<NT),(t+2<NT),(t+2<NT));     ENDW(t+1); ROT();
  }
  STEP(pB0,pB1,pA0,pA1,NT-1,false,false,false);
  { float sacc=pB0[0]+pB0[1]; _Pragma("unroll") for(int r=2;r<16;++r)sacc+=pB0[r]; _Pragma("unroll") for(int r=0;r<16;++r)sacc+=pB1[r]; l_reg+=sacc;
    pw0=(u32x4){PKW(pB0,0),PKW(pB0,2),PKW(pB0,4),PKW(pB0,6)};pw1=(u32x4){PKW(pB0,8),PKW(pB0,10),PKW(pB0,12),PKW(pB0,14)};pw2=(u32x4){PKW(pB1,0),PKW(pB1,2),PKW(pB1,4),PKW(pB1,6)};pw3=(u32x4){PKW(pB1,8),PKW(pB1,10),PKW(pB1,12),PKW(pB1,14)};
    SBAR(); pv(o,vb0+sl_cur,PAF(0),PAF(1),PAF(2),PAF(3)); }
  #undef PKW
  #undef PAF
  #undef VFR
  #undef PIN
  #undef MX3
  #undef GAPA
  #undef GAPB
  #undef EX
  #undef VRD
  #undef KRD
  #undef STEP
  #undef ENDW
  {auto rr=__builtin_amdgcn_permlane32_swap(__float_as_uint(l_reg),__float_as_uint(l_reg),false,false);l_reg=__uint_as_float(rr[0])+__uint_as_float(rr[1]);}
  if(hi==0)wsf[32+r32]=l_reg;asm volatile("s_waitcnt lgkmcnt(0)":::"memory");
  float rli[16];
  #pragma unroll
  for(int r=0;r<16;++r)rli[r]=__builtin_amdgcn_rcpf(wsf[32+crow(r,hi)]);
  bf16*Ow=O+(rowbase+q0+wid*QBLK)*OP+h*D; const bf16*Gw=G+(rowbase+q0+wid*QBLK)*GP+h*D;
  { bf16*stg=(bf16*)(shm+LDS_OST)+wid*2048;
    #pragma unroll
    for(int r=0;r<16;++r){const int orow=crow(r,hi);
      #pragma unroll
      for(int d0=0;d0<2;++d0)stg[orow*64+d0*32+r32]=__float2bfloat16(o[d0][r]*rli[r]);}
    asm volatile("s_waitcnt lgkmcnt(0)":::"memory");
    #pragma unroll
    for(int i=0;i<4;++i){const int row=i*8+(lane>>3),ch=lane&7; u32x4 v=*(const u32x4*)(stg+row*64+ch*8); const u32x4 g=*(const u32x4*)(Gw+(long)row*GP+ch*8);
      _Pragma("unroll") for(int j=0;j<4;++j){ const float o0=__uint_as_float(v[j]<<16),o1=__uint_as_float(v[j]&0xffff0000u),g0=__uint_as_float(g[j]<<16),g1=__uint_as_float(g[j]&0xffff0000u);
        const float s0=g0*__builtin_amdgcn_rcpf(1.f+__builtin_amdgcn_exp2f(-1.4426950408889634f*g0)),s1=g1*__builtin_amdgcn_rcpf(1.f+__builtin_amdgcn_exp2f(-1.4426950408889634f*g1)); v[j]=cvtpk_s(o0*s0,o1*s1);}
      ATTN_STORE16(Ow+(long)row*OP+ch*8,v);} }
  __builtin_amdgcn_s_setprio(0);
  asm volatile("s_waitcnt lgkmcnt(0)\n\ts_barrier":::"memory");
  #undef DMA_K
  #undef DMA_V
  #undef CMASK
  #undef START
  #undef RESC
  #undef ROT
}
constexpr int ATTN_LDS_BYTES=LDS_BYTES;
struct AttnTensors { const bf16* Q; const bf16* K; const bf16* V; bf16* O; const bf16* G; float cshift; };
struct AttnUnit { int bh; int qb; };
struct StaticOrder {
  int vcu,G;
  __device__ __forceinline__ explicit StaticOrder(int grid,int block):vcu((grid%8==0)?(block%8)*(grid/8)+block/8:block),G(grid){}
  __device__ __forceinline__ bool next(int i,AttnUnit&u)const{ const int NU=BATCH*NHEAD*NQB; const int per=(NU+G-1)/G; if(i>=per)return false; const int id=vcu*per+i; if(id>=NU)return false; u.bh=id/NQB; u.qb=id%NQB; return true; }
  __device__ __forceinline__ void a_ready(const AttnUnit&)const{}
  __device__ __forceinline__ void done(const AttnUnit&)const{}
};
template<class Sched,int THRL=8> __device__ __forceinline__ void attn_phase(char*lds,const AttnTensors&T,const Sched&S){
  AttnUnit u;
  for(int i=0;S.next(i,u);++i){ S.a_ready(u); attn_unit<THRL>(u.bh/NHEAD,u.bh%NHEAD,u.qb,T.Q,T.K,T.V,T.O,T.G,T.cshift,lds); S.done(u); }
}
#undef SBAR
#undef WAIT_BAR
}
#ifndef MK_SPLIT
#define MK_SPLIT 0
#endif
constexpr int NWAVES = 8;
constexpr int BATCH = 2, SEQ = 16384, DMODEL = 1024, M = BATCH * SEQ, DIN = 2816, DEPTH = 2;
constexpr float EPS = 1e-6f;
constexpr int NPHASE = 1 + 5 * DEPTH;
constexpr size_t MiB = 1u << 20;
constexpr size_t WS_TAB = 0;
constexpr size_t WS_CTL = 512 * 1024, CTL_ZERO_BYTES = 16384;
constexpr size_t WS_WIN = 1 * MiB;
constexpr size_t WS_WOUT = 12 * MiB;
constexpr size_t WS_XN = 16 * MiB;
constexpr size_t WS_Q = 80 * MiB;
constexpr size_t WS_KV = 112 * MiB;
constexpr size_t WS_R = 128 * MiB;
constexpr size_t WS_MO = 256 * MiB;
constexpr size_t WS_END = 320 * MiB;
constexpr int LDS_BYTES = 147456;
constexpr int MISC_OFF = 131072 + 320;

#define LAS __attribute__((address_space(3)))
typedef unsigned short bf16;
typedef unsigned u32x4 __attribute__((ext_vector_type(4)));
typedef unsigned u32x2 __attribute__((ext_vector_type(2)));
typedef float f32x4 __attribute__((ext_vector_type(4)));
typedef float f32x2 __attribute__((ext_vector_type(2)));
typedef float f32x16 __attribute__((ext_vector_type(16)));
typedef short bf16x8 __attribute__((ext_vector_type(8)));

__device__ __forceinline__ float bflo(unsigned v) { return __uint_as_float(v << 16); }
__device__ __forceinline__ float bfhi(unsigned v) { return __uint_as_float(v & 0xffff0000u); }
__device__ __forceinline__ float bf1(unsigned short v) { return __uint_as_float(((unsigned)v) << 16); }
__device__ __forceinline__ unsigned pk2(float lo, float hi) { return pg8::cvt_pk_bf16(lo, hi); }
__device__ __forceinline__ float sigmoid_(float x) { return __builtin_amdgcn_rcpf(1.f + __builtin_amdgcn_exp2f(-1.4426950408889634f * x)); }
__device__ __forceinline__ float silu_(float x) { return x * sigmoid_(x); }
__device__ __forceinline__ float gelu_(float v) {
    const float av = __builtin_fabsf(v), t = __builtin_amdgcn_rcpf(av * 0.2316418882f + 1.0f);
    float q = t * 0.5307027145f + (-0.7265760135f); q = q * t + 0.7107068705f; q = q * t + (-0.142248368f); q = q * t + 0.127414796f; q = q * t;
    const float e = __builtin_amdgcn_exp2f((v * v) * (-0.72134752044f));
    const float m = v * (q * e);
    return v < 0.f ? m : v - m;
}
__device__ __forceinline__ float wave_sum(float v) {
#pragma unroll
    for (int o = 1; o < 64; o <<= 1) v += __shfl_xor(v, o);
    return v;
}
__device__ __forceinline__ int crow_(int r, int hi) { return (r & 3) + 8 * (r >> 2) + 4 * hi; }

__device__ __forceinline__ void p0_transpose_item(const float* W, int K, int N, bf16* WT, LAS float* scr, int item, int lane) {
    const int nblk = N / 32, kb = item / nblk, nb = item % nblk, k0 = 64 * kb, n0 = 32 * nb;
#pragma unroll 8
    for (int i = 0; i < 32; ++i) { const int kk = 2 * i + (lane >> 5); scr[kk * 33 + (lane & 31)] = __builtin_nontemporal_load(W + (size_t)(k0 + kk) * N + n0 + (lane & 31)); }
    asm volatile("s_waitcnt lgkmcnt(0)" ::: "memory");
    const int c = lane & 7;
#pragma unroll
    for (int j = 0; j < 4; ++j) { const int n = (lane >> 3) + 8 * j; const LAS float* s = scr + (8 * c) * 33 + n;
        u32x4 o; o.x = pk2(s[0 * 33], s[1 * 33]); o.y = pk2(s[2 * 33], s[3 * 33]); o.z = pk2(s[4 * 33], s[5 * 33]); o.w = pk2(s[6 * 33], s[7 * 33]);
        *(u32x4*)(WT + (size_t)(n0 + n) * K + k0 + 8 * c) = o; }
    asm volatile("s_waitcnt lgkmcnt(0)" ::: "memory");
}

constexpr int NR = 4;
__device__ __forceinline__ void norm_phase(int mode, const float* xin, const bf16* mo, const float* gpost, const float* gpre, float* xout, bf16* xn, int gw, int NGW, int lane_in) {
    int lane = lane_in; asm volatile("" : "+v"(lane));
    for (int m0 = gw; m0 < M; m0 += NR * NGW) {
        f32x4 x[NR][4]; u32x2 yw[NR][4];
#pragma unroll
        for (int k = 0; k < NR; ++k) { const size_t m = (size_t)(m0 + k * NGW);
#pragma unroll
            for (int j = 0; j < 4; ++j) x[k][j] = __builtin_nontemporal_load((const f32x4*)(xin + m * DMODEL + 4 * lane + 256 * j));
            if (mode >= 1) {
#pragma unroll
                for (int j = 0; j < 4; ++j) yw[k][j] = __builtin_nontemporal_load((const u32x2*)(mo + m * DMODEL + 4 * lane + 256 * j)); } }
#pragma unroll
        for (int k = 0; k < NR; ++k) { const size_t m = (size_t)(m0 + k * NGW);
            if (mode >= 1) {
                f32x4 y[4]; float ss = 0.f;
#pragma unroll
                for (int j = 0; j < 4; ++j) { const u32x2 w = yw[k][j]; y[j] = (f32x4){bflo(w.x), bfhi(w.x), bflo(w.y), bfhi(w.y)};
                    ss += (y[j].x * y[j].x + y[j].y * y[j].y) + (y[j].z * y[j].z + y[j].w * y[j].w); }
                const float r = 1.0f / sqrtf(wave_sum(ss) * (1.f / DMODEL) + EPS);
#pragma unroll
                for (int j = 0; j < 4; ++j) { const f32x4 g = *(const f32x4*)(gpost + 4 * lane + 256 * j); x[k][j] = x[k][j] + y[j] * r * g;
                    __builtin_nontemporal_store(x[k][j], (f32x4*)(xout + m * DMODEL + 4 * lane + 256 * j)); }
            }
            if (mode <= 1) {
                float ss = 0.f;
#pragma unroll
                for (int j = 0; j < 4; ++j) ss += (x[k][j].x * x[k][j].x + x[k][j].y * x[k][j].y) + (x[k][j].z * x[k][j].z + x[k][j].w * x[k][j].w);
                const float r = 1.0f / sqrtf(wave_sum(ss) * (1.f / DMODEL) + EPS);
#pragma unroll
                for (int j = 0; j < 4; ++j) { const f32x4 g = *(const f32x4*)(gpre + 4 * lane + 256 * j); const f32x4 v = x[k][j] * r * g;
                    u32x2 w; w.x = pk2(v.x, v.y); w.y = pk2(v.z, v.w); *(u32x2*)(xn + m * DMODEL + 4 * lane + 256 * j) = w; }
            }
        }
    }
}

struct ChunkParams { bf16* Q; bf16* KV; const bf16* R; bf16* MIX; const f32x2* tab; const float *q_norm, *k_norm, *conv_dw, *conv_dw_b, *conv_ln_g, *conv_ln_b, *sg_ln_g, *sg_ln_b, *sg_w, *sg_b; };
__device__ __forceinline__ void chunk_phase(LAS unsigned char* lds, const ChunkParams& P, int vcu, int G, int tid_in) {
    int tid = tid_in; asm volatile("" : "+v"(tid));
    int lane = tid & 63, wave = __builtin_amdgcn_readfirstlane(tid >> 6);
#define RELAUNDER() do { asm volatile("" : "+v"(tid)); lane = tid & 63; wave = __builtin_amdgcn_readfirstlane(tid >> 6); } while (0)
    for (int ch = vcu; ch < M / 128; ch += G) {
        RELAUNDER();
        const int row0 = ch * 128, t0 = (ch % (SEQ / 128)) * 128;
        LAS unsigned short* glu = (LAS unsigned short*)lds;
        LAS float* wl = (LAS float*)(lds + 81920);
        LAS f32x2* tabl = (LAS f32x2*)(lds + 116736);
        {
            f32x2 tv[3]; f32x4 wv[4];
#pragma unroll
            for (int k = 0; k < 3; ++k) { const int it = tid + 512 * k; const int e = it >> 4, i = it & 15; const int pos = e < 2 ? (t0 >> 6) + e : e - 2; tv[k] = (it < 66 * 16) ? P.tab[pos * 16 + i] : (f32x2){0.f, 0.f}; }
#pragma unroll
            for (int k = 0; k < 4; ++k) { const int it = tid + 512 * k; wv[k] = (it < 31 * 64) ? ((const f32x4*)P.conv_dw)[it] : (f32x4){0.f, 0.f, 0.f, 0.f}; }
#pragma unroll
            for (int k = 0; k < 3; ++k) { const int it = tid + 512 * k; if (it < 66 * 16) tabl[it] = tv[k]; }
#pragma unroll
            for (int k = 0; k < 4; ++k) { const int it = tid + 512 * k; if (it < 31 * 64) ((LAS f32x4*)wl)[it] = wv[k]; }
        }
        __syncthreads();
        RELAUNDER();
        {
          for (int kb = 0; kb < 6; kb += 2) {
            u32x4 raw[2][4];
#pragma unroll
            for (int k = 0; k < 2; ++k) { const int id = tid + 512 * (kb + k); if (id >= 2560) continue; const int vec = id >> 1, half = id & 1, tok = vec / 10, hh = vec - tok * 10;
                const bf16* p = (hh < 8) ? P.Q + (size_t)(row0 + tok) * 512 + hh * 64 + half * 32 : P.KV + (size_t)(row0 + tok) * 256 + (hh - 8) * 64 + half * 32;
#pragma unroll
                for (int j = 0; j < 4; ++j) raw[k][j] = ((const u32x4*)p)[j]; }
#pragma unroll
            for (int k = 0; k < 2; ++k) { const int id = tid + 512 * (kb + k); if (id >= 2560) continue; const int vec = id >> 1, half = id & 1, tok = vec / 10, hh = vec - tok * 10;
                bf16* p = (hh < 8) ? P.Q + (size_t)(row0 + tok) * 512 + hh * 64 + half * 32 : P.KV + (size_t)(row0 + tok) * 256 + (hh - 8) * 64 + half * 32;
                const float* gn = ((hh < 8) ? P.q_norm : P.k_norm) + half * 32;
                float x[32];
#pragma unroll
                for (int j = 0; j < 4; ++j)
#pragma unroll
                    for (int i = 0; i < 4; ++i) { x[8 * j + 2 * i] = bflo(raw[k][j][i]); x[8 * j + 2 * i + 1] = bfhi(raw[k][j][i]); }
                float ss = 0.f;
#pragma unroll
                for (int i = 0; i < 32; ++i) ss += x[i] * x[i];
                ss += __shfl_xor(ss, 1);
                const float rinv = 1.0f / sqrtf(ss * (1.f / 64.f) + EPS);
                const LAS f32x2* tp = tabl + (half ? 2 + (tok & 63) : (tok >> 6)) * 16;
                const float sc = (hh < 8) ? attn_body::C2 : 1.f;
#pragma unroll
                for (int i = 0; i < 16; ++i) { const f32x2 cs = tp[i]; const float a = x[i] * rinv * gn[i], b = x[i + 16] * rinv * gn[i + 16];
                    x[i] = (a * cs.x - b * cs.y) * sc; x[i + 16] = (b * cs.x + a * cs.y) * sc; }
#pragma unroll
                for (int j = 0; j < 4; ++j) { u32x4 o;
#pragma unroll
                    for (int i = 0; i < 4; ++i) o[i] = pk2(x[8 * j + 2 * i], x[8 * j + 2 * i + 1]);
                    ((u32x4*)p)[j] = o; }
            }
          }
        }
        RELAUNDER();
        for (int kb = 0; kb < 12; kb += 4) {
            u32x4 a1[4], a2[4];
#pragma unroll
            for (int k = 0; k < 4; ++k) { const int it = tid + 512 * (kb + k); const int rr = it >> 5, c8 = it & 31; const int t = t0 - 15 + rr;
                a1[k] = a2[k] = (u32x4){0u, 0u, 0u, 0u};
                if (it < 158 * 32 && t >= 0 && t < SEQ) { const bf16* rp = P.R + (size_t)(row0 - 15 + rr) * 2048 + 512 + c8 * 8; a1[k] = __builtin_nontemporal_load((const u32x4*)rp); a2[k] = __builtin_nontemporal_load((const u32x4*)(rp + 256)); } }
#pragma unroll
            for (int k = 0; k < 4; ++k) { const int it = tid + 512 * (kb + k); const int rr = it >> 5, c8 = it & 31; u32x4 o;
#pragma unroll
                for (int j = 0; j < 4; ++j) o[j] = pk2(bflo(a1[k][j]) * sigmoid_(bflo(a2[k][j])), bfhi(a1[k][j]) * sigmoid_(bfhi(a2[k][j])));
                if (it < 158 * 32) *(LAS u32x4*)(glu + rr * 256 + c8 * 8) = o; }
        }
        __syncthreads();
        RELAUNDER();
        {
            const int c0 = 4 * lane;
            const f32x4 cb = *(const f32x4*)(P.conv_dw_b + c0), lg = *(const f32x4*)(P.conv_ln_g + c0), lb = *(const f32x4*)(P.conv_ln_b + c0);
            for (int blk = 0; blk < 4; ++blk) {
                const int p0 = wave * 16 + blk * 4;
                u32x2 gcv[4];
#pragma unroll
                for (int i = 0; i < 4; ++i) gcv[i] = __builtin_nontemporal_load((const u32x2*)(P.R + (size_t)(row0 + p0 + i) * 2048 + 1024 + c0));
                f32x4 o[4]; o[0] = o[1] = o[2] = o[3] = (f32x4){0.f, 0.f, 0.f, 0.f};
                f32x4 w0 = (f32x4){0.f, 0.f, 0.f, 0.f}, w1 = w0, w2 = w0, w3 = w0;
#pragma unroll
                for (int r = 0; r < 34; ++r) {
                    const u32x2 gr = *(const LAS u32x2*)(glu + (p0 + r) * 256 + c0);
                    const f32x4 g = (f32x4){bflo(gr.x), bfhi(gr.x), bflo(gr.y), bfhi(gr.y)};
                    w3 = w2; w2 = w1; w1 = w0; w0 = (r <= 30) ? *(const LAS f32x4*)(wl + r * 256 + c0) : (f32x4){0.f, 0.f, 0.f, 0.f};
                    o[0] += g * w0; o[1] += g * w1; o[2] += g * w2; o[3] += g * w3;
                    if ((r & 3) == 3) asm volatile("" ::: "memory");
                }
#pragma unroll
                for (int i = 0; i < 4; ++i) {
                    const f32x4 h = o[i] + cb;
                    const float mean = wave_sum((h.x + h.y) + (h.z + h.w)) * (1.f / 256.f);
                    const f32x4 d = h - mean;
                    const float var = wave_sum((d.x * d.x + d.y * d.y) + (d.z * d.z + d.w * d.w)) * (1.f / 256.f);
                    const f32x4 y = d * (1.0f / sqrtf(var + EPS)) * lg + lb;
                    const size_t row = (size_t)(row0 + p0 + i);
                    const u32x2 gc = gcv[i];
                    u32x2 w; w.x = pk2(silu_(y.x) * silu_(bflo(gc.x)), silu_(y.y) * silu_(bfhi(gc.x))); w.y = pk2(silu_(y.z) * silu_(bflo(gc.y)), silu_(y.w) * silu_(bfhi(gc.y)));
                    __builtin_nontemporal_store(w, (u32x2*)(P.MIX + row * 1024 + 512 + c0));
                }
            }
        }
        __syncthreads();
        RELAUNDER();
        LAS unsigned short* vT = (LAS unsigned short*)lds;
        {
            float lg[4], lb[4];
#pragma unroll
            for (int j = 0; j < 4; ++j) { lg[j] = P.sg_ln_g[lane + 64 * j]; lb[j] = P.sg_ln_b[lane + 64 * j]; }
            for (int i0 = 0; i0 < 16; i0 += 8) {
                unsigned short vv[8][4];
#pragma unroll
                for (int i = 0; i < 8; ++i) { const bf16* vr = P.R + (size_t)(row0 + wave * 16 + i0 + i) * 2048 + 1536 + lane;
#pragma unroll
                    for (int j = 0; j < 4; ++j) vv[i][j] = vr[64 * j]; }
#pragma unroll
                for (int i = 0; i < 8; ++i) { const int p = wave * 16 + i0 + i;
                    float v[4]; float s = 0.f;
#pragma unroll
                    for (int j = 0; j < 4; ++j) { v[j] = gelu_(bf1(vv[i][j])); s += v[j]; }
                    const float mean = wave_sum(s) * (1.f / 256.f); float q = 0.f;
#pragma unroll
                    for (int j = 0; j < 4; ++j) { v[j] -= mean; q += v[j] * v[j]; }
                    const float rstd = 1.0f / sqrtf(wave_sum(q) * (1.f / 256.f) + EPS);
#pragma unroll
                    for (int j = 0; j < 4; ++j) vT[(lane + 64 * j) * 136 + p] = (unsigned short)(pk2(v[j] * rstd * lg[j] + lb[j], 0.f) & 0xffffu);
                }
            }
        }
        __syncthreads();
        RELAUNDER();
        {
            const int hd = wave >> 1, ph = wave & 1, r32 = lane & 31, hi = lane >> 5;
            f32x16 acc[2][2];
#pragma unroll
            for (int a = 0; a < 2; ++a)
#pragma unroll
                for (int b = 0; b < 2; ++b)
#pragma unroll
                    for (int r = 0; r < 16; ++r) acc[a][b][r] = 0.f;
            const float* Wh = P.sg_w + (size_t)hd * 128 * 128;
#pragma unroll 2
            for (int kk = 0; kk < 8; ++kk) {
                bf16x8 a[2], b[2];
#pragma unroll
                for (int pi = 0; pi < 2; ++pi) { const float* wp = Wh + (size_t)(64 * ph + 32 * pi + r32) * 128 + 16 * kk + 8 * hi; const f32x4 x0 = *(const f32x4*)wp, x1 = *(const f32x4*)(wp + 4);
                    u32x4 pk; pk.x = pk2(x0.x, x0.y); pk.y = pk2(x0.z, x0.w); pk.z = pk2(x1.x, x1.y); pk.w = pk2(x1.z, x1.w); a[pi] = __builtin_bit_cast(bf16x8, pk); }
#pragma unroll
                for (int di = 0; di < 2; ++di) b[di] = *(const LAS bf16x8*)(vT + (64 * hd + 32 * di + r32) * 136 + 16 * kk + 8 * hi);
#pragma unroll
                for (int pi = 0; pi < 2; ++pi)
#pragma unroll
                    for (int di = 0; di < 2; ++di) acc[pi][di] = __builtin_amdgcn_mfma_f32_32x32x16_bf16(a[pi], b[di], acc[pi][di], 0, 0, 0);
            }
            __syncthreads();
            LAS float* stg = (LAS float*)(lds + wave * 16384);
#pragma unroll
            for (int pi = 0; pi < 2; ++pi)
#pragma unroll
                for (int r = 0; r < 16; ++r) { const int pl = 32 * pi + crow_(r, hi); const float bs = P.sg_b[hd * 128 + 64 * ph + pl];
#pragma unroll
                    for (int di = 0; di < 2; ++di) stg[pl * 64 + 32 * di + r32] = acc[pi][di][r] + bs; }
            asm volatile("s_waitcnt lgkmcnt(0)" ::: "memory");
#pragma unroll 1
            for (int ib = 0; ib < 8; ib += 4) {
                const int d0 = (lane & 7) * 8; u32x4 uu[4], gg[4];
#pragma unroll
                for (int k = 0; k < 4; ++k) { const size_t row = (size_t)(row0 + 64 * ph + (ib + k) * 8 + (lane >> 3));
                    uu[k] = *(const u32x4*)(P.R + row * 2048 + 1280 + 64 * hd + d0); gg[k] = *(const u32x4*)(P.R + row * 2048 + 1792 + 64 * hd + d0); }
#pragma unroll
                for (int k = 0; k < 4; ++k) { const int pl = (ib + k) * 8 + (lane >> 3); const size_t row = (size_t)(row0 + 64 * ph + pl);
                    const f32x4 m0 = *(const LAS f32x4*)(stg + pl * 64 + d0), m1 = *(const LAS f32x4*)(stg + pl * 64 + d0 + 4);
                    u32x4 o;
                    o[0] = pk2(gelu_(bflo(uu[k][0])) * m0[0] * silu_(bflo(gg[k][0])), gelu_(bfhi(uu[k][0])) * m0[1] * silu_(bfhi(gg[k][0])));
                    o[1] = pk2(gelu_(bflo(uu[k][1])) * m0[2] * silu_(bflo(gg[k][1])), gelu_(bfhi(uu[k][1])) * m0[3] * silu_(bfhi(gg[k][1])));
                    o[2] = pk2(gelu_(bflo(uu[k][2])) * m1[0] * silu_(bflo(gg[k][2])), gelu_(bfhi(uu[k][2])) * m1[1] * silu_(bfhi(gg[k][2])));
                    o[3] = pk2(gelu_(bflo(uu[k][3])) * m1[2] * silu_(bflo(gg[k][3])), gelu_(bfhi(uu[k][3])) * m1[3] * silu_(bfhi(gg[k][3])));
                    *(u32x4*)(P.MIX + row * 1024 + 768 + 64 * hd + d0) = o;
                    asm volatile("" ::: "memory"); }
            }
        }
        __syncthreads();
    }
}

#define XB_TMO      128
#define XB_XCNT(j)  (256  + 64 * (j))
#define XB_XSUB(j)  (1280 + 64 * (j))
#define XB_XGEN(j)  (2304 + 64 * (j))
#define XB_TOP      3328
#define XB_TOPGEN   3392
#define XCD_BAR_WORDS 3456
#define XB_SPIN_CAP (1u << 18)

__device__ __forceinline__ unsigned xb_ld(unsigned* p)              { return __hip_atomic_load(p, __ATOMIC_RELAXED, __HIP_MEMORY_SCOPE_AGENT); }
__device__ __forceinline__ unsigned xb_add(unsigned* p, unsigned v) { return __hip_atomic_fetch_add(p, v, __ATOMIC_RELAXED, __HIP_MEMORY_SCOPE_AGENT); }
__device__ __forceinline__ unsigned xb_xcc_id() { return (unsigned)__builtin_amdgcn_s_getreg((3 << 11) | 20) & 0xFu; }
#define XB_SPIN(cond, bar) do { unsigned _sp = 0; while (cond) { __builtin_amdgcn_s_sleep(1); \
    if ((++_sp & 255u) == 0u) { if (xb_ld(&(bar)[XB_TMO])) break; if (_sp > XB_SPIN_CAP) { atomicAdd(&(bar)[XB_TMO], 1u); break; } } } } while (0)

struct XcdBarrier {
    unsigned* bar; unsigned x;
    volatile LAS unsigned* st;
};

__device__ __forceinline__ XcdBarrier xcd_barrier_post(unsigned* bar, volatile LAS unsigned* st) {
    XcdBarrier b; b.bar = bar; b.x = xb_xcc_id(); b.st = st;
    if (threadIdx.x == 0) (void)xb_add(&bar[XB_XCNT(b.x)], 1u);
    return b;
}
__device__ __forceinline__ void xcd_barrier_complete(unsigned* bar, unsigned x, unsigned& nloc, unsigned& nx) {
    const unsigned G = gridDim.x * gridDim.y * gridDim.z;
    unsigned sum, cnt, mine, sp = 0u;
    for (;;) {
        sum = 0u; cnt = 0u; mine = 0u;
#pragma unroll
        for (unsigned j = 0; j < 16; ++j) { const unsigned c = xb_ld(&bar[XB_XCNT(j)]); sum += c; cnt += (c > 0u) ? 1u : 0u; mine = (j == x) ? c : mine; }
        if (sum == G) break;
        __builtin_amdgcn_s_sleep(1);
        if ((++sp & 255u) == 0u) { if (xb_ld(&bar[XB_TMO])) break; if (sp > XB_SPIN_CAP) { atomicAdd(&bar[XB_TMO], 1u); break; } }
    }
    nloc = mine > 0u ? mine : 1u; nx = cnt > 0u ? cnt : 1u;
}

__device__ __forceinline__ void xcd_barrier(const XcdBarrier& b) {
    asm volatile("s_waitcnt vmcnt(0)" ::: "memory");
    __syncthreads();
    if (threadIdx.x == 0) {
        unsigned* bar = b.bar;
        __builtin_amdgcn_s_waitcnt(0);
        unsigned nloc = b.st[0], nx = b.st[1];
        if (nloc == 0u) { xcd_barrier_complete(bar, b.x, nloc, nx); b.st[0] = nloc; b.st[1] = nx; }
        const unsigned old = xb_add(&bar[XB_XSUB(b.x)], 1u);
        const unsigned gen = old / nloc;
        if (old + 1u == (gen + 1u) * nloc) {
            __builtin_amdgcn_fence(__ATOMIC_RELEASE, "agent");
            asm volatile("s_waitcnt vmcnt(0)" ::: "memory");
            const unsigned og = xb_add(&bar[XB_TOP], 1u);
            const unsigned tg = og / nx;
            if (og + 1u == (tg + 1u) * nx) xb_add(&bar[XB_TOPGEN], 1u);
            else XB_SPIN(xb_ld(&bar[XB_TOPGEN]) == tg, bar);
            __builtin_amdgcn_fence(__ATOMIC_ACQUIRE, "agent");
            xb_add(&bar[XB_XGEN(b.x)], 1u);
            asm volatile("s_waitcnt vmcnt(0)" ::: "memory");
        } else {
            XB_SPIN(xb_ld(&bar[XB_XGEN(b.x)]) == gen, bar);
            __builtin_amdgcn_fence(__ATOMIC_ACQUIRE, "agent");
            asm volatile("s_waitcnt vmcnt(0)" ::: "memory");
        }
    }
    __syncthreads();
}

struct Args { const float* in[15]; float* out; unsigned char* ws; int ph_lo, ph_hi; };
__global__ void __launch_bounds__(NWAVES * 64, 2) mega_fwd(Args args) {
    extern __shared__ __attribute__((aligned(16))) unsigned char lds[];
    LAS unsigned char* L = (LAS unsigned char*)lds;
    const int tid = threadIdx.x, lane = tid & 63, wave = __builtin_amdgcn_readfirstlane(tid >> 6);
    const int G = gridDim.x, bx = blockIdx.x, vcu = (G % 8 == 0) ? (bx % 8) * (G / 8) + bx / 8 : bx;
    const int gw = vcu * NWAVES + wave, NGW = G * NWAVES;
    unsigned char* ws = args.ws;
    const float* x = args.in[0]; const float* pre_norm = args.in[1]; const float* post_norm = args.in[2]; const float* w_in = args.in[3]; const float* w_out = args.in[4];
    bf16* WIN_T = (bf16*)(ws + WS_WIN); bf16* WOUT_T = (bf16*)(ws + WS_WOUT); bf16* XN = (bf16*)(ws + WS_XN); bf16* MIX = XN;
    bf16* Qb = (bf16*)(ws + WS_Q); bf16* KVb = (bf16*)(ws + WS_KV); bf16* Rb = (bf16*)(ws + WS_R); bf16* MO = (bf16*)(ws + WS_MO);
    f32x2* tab = (f32x2*)(ws + WS_TAB);
    float* out = args.out;
    const int lo = args.ph_lo, hi = args.ph_hi;
    volatile LAS unsigned* MISC = (volatile LAS unsigned*)(L + MISC_OFF);
    if (tid < 32) MISC[tid] = 0u;
    __syncthreads();
#if !MK_SPLIT
    if (bx == 0) { for (int w = tid; w < XCD_BAR_WORDS; w += NWAVES * 64) __hip_atomic_store((unsigned*)(ws + WS_CTL) + w, 0u, __ATOMIC_RELAXED, __HIP_MEMORY_SCOPE_AGENT); __threadfence(); }
    cg::this_grid().sync();
#endif
    XcdBarrier bar = xcd_barrier_post((unsigned*)(ws + WS_CTL), MISC + 8);
#define IN(k) (lo <= (k) && (k) < hi)
#if MK_SPLIT
#define SEAM(k) do { } while (0)
#else
#define SEAM(k) do { if (IN(k) && IN((k) + 1)) { xcd_barrier(bar); } } while (0)
#endif
    if (IN(0)) {
        LAS float* scr = (LAS float*)(L + wave * 16384);
        constexpr int I_IN = (DMODEL / 64) * (DIN / 32), I_OUT = (DMODEL / 64) * (DMODEL / 32), I_L = I_IN + I_OUT;
        for (int it = gw; it < DEPTH * I_L; it += NGW) { const int l = it / I_L, r = it - l * I_L;
            if (r < I_IN) p0_transpose_item(w_in + (size_t)l * DMODEL * DIN, DMODEL, DIN, WIN_T + (size_t)l * DIN * DMODEL, scr, r, lane);
            else p0_transpose_item(w_out + (size_t)l * DMODEL * DMODEL, DMODEL, DMODEL, WOUT_T + (size_t)l * DMODEL * DMODEL, scr, r - I_IN, lane); }
        for (int idx = bx * (NWAVES * 64) + tid; idx < 256 * 16; idx += G * NWAVES * 64) { const int pos = idx >> 4, i = idx & 15;
            const float inv = exp2f(-(float)i * (13.287712379549449f / 16.0f));
            const float ang = (float)pos * inv;
            double rev = (double)ang * 0.15915494309189535; rev -= __builtin_rint(rev);
            tab[idx] = (f32x2){__builtin_amdgcn_cosf((float)rev), __builtin_amdgcn_sinf((float)rev)}; }
        norm_phase(0, x, nullptr, nullptr, pre_norm, nullptr, XN, gw, NGW, lane);
    }
    SEAM(0);
#pragma unroll 1
    for (int l = 0; l < DEPTH; ++l) {
        const int pb = 1 + 5 * l;
        if (IN(pb)) {
            pg8::Gemm g{XN, WIN_T + (size_t)l * DIN * DMODEL, M, DIN, DMODEL}; pg8::StaticOrder S; S.init(M, DIN, G, bx);
            pg8::EpiProj E{Qb, KVb, Rb};
            pg8::gemm_phase<pg8::EpiProj, pg8::StaticOrder, PG8_ALIGN, PG8_SP2>(L, g, S, E);
#if defined(DUP_GEMM)
            if (l == 0) { __syncthreads(); pg8::gemm_phase<pg8::EpiProj, pg8::StaticOrder, PG8_ALIGN, PG8_SP2>(L, g, S, E); }
#endif
        }
        SEAM(pb);
        if (IN(pb + 1)) {
            ChunkParams P{Qb, KVb, Rb, MIX, tab, args.in[5] + l * 64, args.in[6] + l * 64, args.in[7] + (size_t)l * 31 * 256, args.in[8] + l * 256, args.in[9] + l * 256, args.in[10] + l * 256,
                          args.in[11] + l * 256, args.in[12] + l * 256, args.in[13] + (size_t)l * 4 * 128 * 128, args.in[14] + l * 4 * 128};
            chunk_phase(L, P, vcu, G, tid);
#if defined(DUP_CHUNK)
            if (l == 1) { ChunkParams P2 = P; P2.Q = (bf16*)(ws + WS_MO); P2.KV = (bf16*)(ws + WS_MO + 40 * MiB); chunk_phase(L, P2, vcu, G, tid); }
#endif
        }
        SEAM(pb + 1);
        if (IN(pb + 2)) {
            float gq = __builtin_fabsf(args.in[5][l * 64 + lane]), gk = __builtin_fabsf(args.in[6][l * 64 + lane]);
#pragma unroll
            for (int o = 1; o < 64; o <<= 1) { gq = __builtin_fmaxf(gq, __shfl_xor(gq, o)); gk = __builtin_fmaxf(gk, __shfl_xor(gk, o)); }
            const float cshift = __builtin_fmaxf(0.f, 8.0f * 1.4426950408889634f * gq * gk - 24.0f);
            const attn_body::AttnTensors AT{(const attn_body::bf16*)Qb, (const attn_body::bf16*)KVb, (const attn_body::bf16*)(KVb + 128), (attn_body::bf16*)MIX, (const attn_body::bf16*)Rb, cshift};
            const attn_body::StaticOrder S(G, bx);
            attn_body::attn_phase<attn_body::StaticOrder>((char*)lds, AT, S);
#if defined(DUP_ATTN)
            if (l == 0) { __syncthreads(); attn_body::attn_phase<attn_body::StaticOrder>((char*)lds, AT, S); }
#endif
        }
        SEAM(pb + 2);
        if (IN(pb + 3)) {
            pg8::Gemm g{MIX, WOUT_T + (size_t)l * DMODEL * DMODEL, M, DMODEL, DMODEL}; pg8::StaticOrder S; S.init(M, DMODEL, G, bx);
            pg8::EpiBf16<0> E{MO, DMODEL, nullptr, 0, 0, 1.f};
            pg8::gemm_phase<pg8::EpiBf16<0>, pg8::StaticOrder, PG8_ALIGN, PG8_SP2>(L, g, S, E);
        }
        SEAM(pb + 3);
        if (IN(pb + 4)) {
            if (l + 1 < DEPTH) norm_phase(1, l == 0 ? x : out, MO, post_norm + l * DMODEL, pre_norm + (l + 1) * DMODEL, out, XN, gw, NGW, lane);
#if defined(DUP_NORM)
            if (l == 0) norm_phase(1, x, MO, post_norm, pre_norm + DMODEL, out, XN, gw, NGW, lane);
#endif
            else norm_phase(2, l == 0 ? x : out, MO, post_norm + l * DMODEL, nullptr, out, nullptr, gw, NGW, lane);
        }
        if (l + 1 < DEPTH) SEAM(pb + 4);
    }
#undef IN
#undef SEAM
}

extern "C" void kernel_launch(void* const* d_in, const int* in_sizes, int n_in, void* d_out, int out_size, void* d_ws, size_t ws_size, hipStream_t stream) {
    static int grid = 0;
    if (grid == 0) {
        if (n_in != 15 || in_sizes[0] != M * DMODEL || out_size != M * DMODEL || ws_size < WS_END) { fprintf(stderr, "kernel_launch: unexpected problem shape / workspace (%d inputs, ws %zu)\n", n_in, ws_size); grid = -1; return; }
        int dev = 0, cus = 0, per_cu = 0;
        if (hipGetDevice(&dev) != hipSuccess || hipDeviceGetAttribute(&cus, hipDeviceAttributeMultiprocessorCount, dev) != hipSuccess) { grid = -1; return; }
        if (hipFuncSetAttribute((const void*)mega_fwd, hipFuncAttributeMaxDynamicSharedMemorySize, LDS_BYTES) != hipSuccess) { fprintf(stderr, "kernel_launch: hipFuncSetAttribute failed\n"); grid = -1; return; }
        if (hipOccupancyMaxActiveBlocksPerMultiprocessor(&per_cu, (const void*)mega_fwd, NWAVES * 64, LDS_BYTES) != hipSuccess || per_cu < 1) { fprintf(stderr, "kernel_launch: occupancy query gave %d\n", per_cu); per_cu = 1; }
        (void)hipGetLastError();
        grid = cus * per_cu;
        if (M % (NR * grid * NWAVES) != 0) { grid = 256; }
        if (grid > cus * per_cu || M % (NR * grid * NWAVES) != 0) { fprintf(stderr, "kernel_launch: unsupported device geometry (%d CUs x %d)\n", cus, per_cu); grid = -1; return; }
    }
    if (grid < 0) return;
    Args a{};
    for (int i = 0; i < 15; ++i) a.in[i] = (const float*)d_in[i];
    a.out = (float*)d_out; a.ws = (unsigned char*)d_ws;
    void* kargs[] = {&a};
#if MK_SPLIT
    for (int ph = 0; ph < NPHASE; ++ph) { a.ph_lo = ph; a.ph_hi = ph + 1;
        hipError_t e = hipLaunchCooperativeKernel((const void*)mega_fwd, dim3(grid), dim3(NWAVES * 64), kargs, LDS_BYTES, stream);
        if (e != hipSuccess) { fprintf(stderr, "kernel_launch: launch %d failed: %s\n", ph, hipGetErrorString(e)); break; } }
#else
    a.ph_lo = 0; a.ph_hi = NPHASE;
    hipError_t e = hipLaunchCooperativeKernel((const void*)mega_fwd, dim3(grid), dim3(NWAVES * 64), kargs, LDS_BYTES, stream);
    if (e != hipSuccess) fprintf(stderr, "kernel_launch: cooperative launch failed: %s (grid %d)\n", hipGetErrorString(e), grid);
#endif
}
```

```cpp
#include <hip/hip_runtime.h>
#include <hip/hip_cooperative_groups.h>
#include <cstdio>
#include <cstdint>
namespace cg = cooperative_groups;
#include <hip/hip_bf16.h>
#include <cmath>
namespace pg8 {
#define PG8_LAS __attribute__((address_space(3)))
typedef unsigned short bf16_t;
typedef short bf16x8 __attribute__((ext_vector_type(8)));
typedef float f32x4 __attribute__((ext_vector_type(4)));
typedef unsigned u32x4 __attribute__((ext_vector_type(4)));
constexpr int BM = 256, BK = 64, HALF = 128, HTB = HALF * BK * 2  , STAGE_BYTES = 8 * HTB, NXCD = 8, WGM = 8;

__host__ __device__ __forceinline__ int lds_byte(int r, int c) { const int st = (r >> 4) * 2 + (c >> 5), rr = r & 15, cc = c & 31, ob = rr * 64 + cc * 2; return st * 1024 + (ob ^ (((ob >> 9) & 1) << 5)); }
__host__ __device__ __forceinline__ void stage_rc(int b, int& R, int& C) { const int st = b / 1024, sb = b % 1024, swz = sb ^ (((sb >> 9) & 1) << 5); R = (st >> 1) * 16 + swz / 64; C = (st & 1) * 32 + (swz % 64) / 2; }
__host__ __device__ __forceinline__ int perm32(int rho) { const int n = rho >> 4, i = rho & 15; return 8 * (i >> 2) + 4 * n + (i & 3); }

struct Unit { int pm, pn; };
struct Gemm { const bf16_t* A; const bf16_t* Bt; int M, N, K; int ld = 0; };

struct StaticOrder {
    int nM, nN, nwg, G, c;
    __host__ __device__ void init(int M, int N, int G_, int c_) { nM = M / BM; nN = N / BM; nwg = nM * nN; G = G_; c = c_; }
    __host__ __device__ bool next(int i, Unit& u) const {
        const long L = (long)i * G + c; if (L >= nwg) return false;
        int wgid = (int)L; { const int q = nwg / NXCD, r = nwg % NXCD, xcd = wgid % NXCD, off = wgid / NXCD; wgid = (xcd < r ? xcd * (q + 1) : r * (q + 1) + (xcd - r) * q) + off; }
        const int nig = WGM * nN, gid = wgid / nig, fm = gid * WGM, gsz = (nM - fm) < WGM ? (nM - fm) : WGM;
        u.pm = fm + ((wgid % nig) % gsz); u.pn = (wgid % nig) / gsz; return true;
    }
    __device__ __forceinline__ void a_ready(const Unit&) const {}
    __device__ __forceinline__ void done(const Unit&) const {}
};

__device__ __forceinline__ unsigned cvt_pk_bf16(float lo, float hi) { unsigned r; asm volatile("v_cvt_pk_bf16_f32 %0, %1, %2" : "=v"(r) : "v"(lo), "v"(hi)); return r; }
typedef float f32x2 __attribute__((ext_vector_type(2)));
__device__ __forceinline__ f32x2 gelu_pk(f32x2 v) {
    const f32x2 av = __builtin_elementwise_abs(v), d = av * 0.2316418882f + 1.0f;
    f32x2 t; t.x = __builtin_amdgcn_rcpf(d.x); t.y = __builtin_amdgcn_rcpf(d.y);
    f32x2 q = t * 0.5307027145f + (-0.7265760135f); q = q * t + 0.7107068705f; q = q * t + (-0.142248368f); q = q * t + 0.127414796f; q = q * t;
    const f32x2 s = (v * v) * (-0.72134752044f);
    f32x2 e; e.x = __builtin_amdgcn_exp2f(s.x); e.y = __builtin_amdgcn_exp2f(s.y);
    const f32x2 m = v * (q * e), r = v - m;
    f32x2 o; o.x = v.x < 0.f ? m.x : r.x; o.y = v.y < 0.f ? m.y : r.y; return o;
}

template <int ACT  > struct EpiBf16 {
    static constexpr bool PERM = true, AFTER_DRAIN = false; static_assert(ACT == 0 || ACT == 1, "EpiBf16: ACT is 0 (none) or 1 (gelu_pk)");
    bf16_t* O; int ldc; const float* bias; int split_cols; size_t split_stride; float scale0;
    __device__ __forceinline__ void operator()(const f32x4 (&acc)[2][2][4][2], const Unit& u, int wr, int wc, int fr, int fq) const {
        const int row0 = u.pm * BM + wr * 64 + fr; int colt = u.pn * BM; bf16_t* base = O;
        float sc = 1.f; if (split_cols) { const int t = colt / split_cols; base += (size_t)t * split_stride; colt -= t * split_cols; if (t == 0) sc = scale0; }
        const int col0 = colt + wc * 32 + 8 * fq, bcol0 = u.pn * BM + wc * 32 + 8 * fq;
        f32x4 bv[2][2];
#pragma unroll
        for (int bj = 0; bj < 2; ++bj)
#pragma unroll
            for (int n = 0; n < 2; ++n) bv[bj][n] = bias ? *(const f32x4*)(bias + bcol0 + bj * HALF + 4 * n) : (f32x4){0.f, 0.f, 0.f, 0.f};
#pragma unroll
        for (int ai = 0; ai < 2; ++ai)
#pragma unroll
            for (int m = 0; m < 4; ++m) { bf16_t* rowp = base + (size_t)(row0 + ai * HALF + m * 16) * ldc + col0;
#pragma unroll
                for (int bj = 0; bj < 2; ++bj) { f32x4 v0 = acc[ai][bj][m][0] + bv[bj][0], v1 = acc[ai][bj][m][1] + bv[bj][1];
                    if (ACT == 1) { f32x2 a = gelu_pk((f32x2){v0[0], v0[1]}), b = gelu_pk((f32x2){v0[2], v0[3]}), c = gelu_pk((f32x2){v1[0], v1[1]}), d = gelu_pk((f32x2){v1[2], v1[3]});
                        v0 = (f32x4){a.x, a.y, b.x, b.y}; v1 = (f32x4){c.x, c.y, d.x, d.y}; }
                    v0 = v0 * sc; v1 = v1 * sc; u32x4 w; w.x = cvt_pk_bf16(v0[0], v0[1]); w.y = cvt_pk_bf16(v0[2], v0[3]); w.z = cvt_pk_bf16(v1[0], v1[1]); w.w = cvt_pk_bf16(v1[2], v1[3]);
                    *(u32x4*)(rowp + bj * HALF) = w; } }
    }
};
struct EpiProj {
    static constexpr bool PERM = true, AFTER_DRAIN = false;
    bf16_t* Q; bf16_t* KV; bf16_t* R;
    __device__ __forceinline__ void operator()(const f32x4 (&acc)[2][2][4][2], const Unit& u, int wr, int wc, int fr, int fq) const {
        bf16_t* base; int ldc, colt;
        if (u.pn < 2) { base = Q; ldc = 512; colt = u.pn * 256; } else if (u.pn == 2) { base = KV; ldc = 256; colt = 0; } else { base = R; ldc = 2048; colt = (u.pn - 3) * 256; }
        const int row0 = u.pm * BM + wr * 64 + fr; const int col0 = colt + wc * 32 + 8 * fq;
#pragma unroll
        for (int ai = 0; ai < 2; ++ai)
#pragma unroll
            for (int m = 0; m < 4; ++m) { bf16_t* rowp = base + (size_t)(row0 + ai * HALF + m * 16) * ldc + col0;
#pragma unroll
                for (int bj = 0; bj < 2; ++bj) { const f32x4 v0 = acc[ai][bj][m][0], v1 = acc[ai][bj][m][1];
                    u32x4 w; w.x = cvt_pk_bf16(v0[0], v0[1]); w.y = cvt_pk_bf16(v0[2], v0[3]); w.z = cvt_pk_bf16(v1[0], v1[1]); w.w = cvt_pk_bf16(v1[2], v1[3]);
                    *(u32x4*)(rowp + bj * HALF) = w; } }
    }
};

struct OneUnit {
    Unit u;
    __host__ __device__ bool next(int i, Unit& o) const { if (i) return false; o = u; return true; }
    __device__ __forceinline__ void a_ready(const Unit&) const {}
    __device__ __forceinline__ void done(const Unit&) const {}
};
template <class Epi, class Sched, bool ALIGN_EPI = false, bool SP2 = false>
__device__ __forceinline__ void gemm_phase(PG8_LAS unsigned char* lds, const Gemm g, const Sched& S, const Epi& E) {
    int tid_l = threadIdx.x; asm volatile("" : "+v"(tid_l));
    const int tid = tid_l, wid = __builtin_amdgcn_readfirstlane(tid >> 6), lane = tid & 63, wr = wid >> 2, wc = wid & 3, fr = lane & 15, fq = lane >> 4;
    const int K = g.K, LD = g.ld ? g.ld : g.K, nt = K / BK;
    unsigned voffA[2], voffB[2];
#pragma unroll
    for (int i = 0; i < 2; ++i) { int R, C; stage_rc(tid * 16 + i * 8192, R, C); const int Rb = Epi::PERM ? ((R & ~31) + perm32(R & 31)) : R;
        voffA[i] = (unsigned)(R * LD + C) * 2u; voffB[i] = (unsigned)(Rb * LD + C) * 2u; }
    const size_t kstep = (size_t)(BK * 2);
    const size_t hstep = (size_t)HALF * LD * 2;
    const size_t tstep = 2 * hstep;
    const unsigned ldsw = (unsigned)wid * 1024u;
    const int aoff = lds_byte(wr * 64 + fr, fq * 8), boff = lds_byte(wc * 32 + fr, fq * 8);
#define PG8_SA(b, h) (((b) * 2 + (h)) * HTB)
#define PG8_SB(b, h) ((4 + (b) * 2 + (h)) * HTB)
#define PG8_STAGE(bufoff, gbase, voff) do { _Pragma("unroll") for (int _i = 0; _i < 2; ++_i) \
        __builtin_amdgcn_global_load_lds((const unsigned*)((const char*)(gbase) + (voff)[_i]), (PG8_LAS unsigned*)(lds + (bufoff) + ldsw + _i * 8192), 16, 0, 0); } while (0)
#define PG8_LDA(dst, b, h) do { _Pragma("unroll") for (int m = 0; m < 4; ++m) _Pragma("unroll") for (int k = 0; k < 2; ++k) dst[m][k] = *(const PG8_LAS bf16x8*)(lds + PG8_SA(b, h) + aoff + m * 2048 + k * 1024); } while (0)
#define PG8_LDB(dst, b, h) do { _Pragma("unroll") for (int n = 0; n < 2; ++n) _Pragma("unroll") for (int k = 0; k < 2; ++k) dst[n][k] = *(const PG8_LAS bf16x8*)(lds + PG8_SB(b, h) + boff + n * 2048 + k * 1024); } while (0)
#define PG8_MMA(ai, bj, At, Bt) do { __builtin_amdgcn_s_setprio(1); _Pragma("unroll") for (int m = 0; m < 4; ++m) _Pragma("unroll") for (int n = 0; n < 2; ++n) _Pragma("unroll") for (int k = 0; k < 2; ++k) \
        acc[ai][bj][m][n] = __builtin_amdgcn_mfma_f32_16x16x32_bf16(Bt[n][k], At[m][k], acc[ai][bj][m][n], 0, 0, 0); __builtin_amdgcn_s_setprio(0); } while (0)
#define PG8_WAIT_V(n) asm volatile("s_waitcnt vmcnt(" #n ")" ::: "memory")
#define PG8_WAIT_L(n) asm volatile("s_waitcnt lgkmcnt(" #n ")" ::: "memory")
#define PG8_BAR __builtin_amdgcn_s_barrier()
#define PG8_SCHED __builtin_amdgcn_sched_barrier(0)
    Unit cur, nxt; int ui = 0;
    if (!S.next(0, cur)) return;
    f32x4 acc[2][2][4][2];
#pragma unroll
    for (int a = 0; a < 2; ++a)
#pragma unroll
        for (int b = 0; b < 2; ++b)
#pragma unroll
            for (int m = 0; m < 4; ++m)
#pragma unroll
                for (int n = 0; n < 2; ++n) acc[a][b][m][n] = (f32x4){0.f, 0.f, 0.f, 0.f};
    bf16x8 At[4][2], B0[2][2], B1[2][2];
    const char* cA = (const char*)g.A + (size_t)cur.pm * tstep; const char* cB = (const char*)g.Bt + (size_t)cur.pn * tstep;
    S.a_ready(cur);
    if constexpr (SP2) {
        PG8_STAGE(PG8_SB(0, 0), cB, voffB); PG8_STAGE(PG8_SB(0, 1), cB + hstep, voffB); PG8_STAGE(PG8_SA(0, 0), cA, voffA); PG8_STAGE(PG8_SA(0, 1), cA + hstep, voffA);
        if (wr == 1) PG8_BAR;
        PG8_WAIT_V(2); PG8_BAR;
        PG8_STAGE(PG8_SB(1, 0), cB + kstep, voffB); PG8_STAGE(PG8_SA(1, 0), cA + kstep, voffA); PG8_STAGE(PG8_SB(1, 1), cB + hstep + kstep, voffB);
        PG8_WAIT_V(6); PG8_BAR;
    } else {
        PG8_STAGE(PG8_SB(0, 0), cB, voffB); PG8_STAGE(PG8_SA(0, 0), cA, voffA); PG8_STAGE(PG8_SB(0, 1), cB + hstep, voffB); PG8_STAGE(PG8_SA(0, 1), cA + hstep, voffA);
        if (wr == 1) PG8_BAR;
        PG8_WAIT_V(4); PG8_BAR;
        PG8_STAGE(PG8_SB(1, 0), cB + kstep, voffB); PG8_STAGE(PG8_SA(1, 0), cA + kstep, voffA); PG8_STAGE(PG8_SB(1, 1), cB + hstep + kstep, voffB);
        PG8_WAIT_V(6); PG8_BAR;
    }
    for (;;) {
        const bool has_next = S.next(ui + 1, nxt);
        const char* nA = has_next ? (const char*)g.A + (size_t)nxt.pm * tstep : cA; const char* nB = has_next ? (const char*)g.Bt + (size_t)nxt.pn * tstep : cB;
        for (int t = 0; t < nt; t += 2) {
            const bool last = (t == nt - 2);
            const char* a1 = cA + (size_t)(t + 1) * kstep;
            const char* a2 = last ? nA : cA + (size_t)(t + 2) * kstep; const char* b2 = last ? nB : cB + (size_t)(t + 2) * kstep;
            const char* a3 = a2 + kstep; const char* b3 = b2 + kstep;
            if (last && has_next) S.a_ready(nxt);
            if constexpr (SP2) {
            PG8_LDB(B0, 0, 0); PG8_LDB(B1, 0, 1); PG8_SCHED; PG8_LDA(At, 0, 0); PG8_STAGE(PG8_SA(1, 1), a1 + hstep, voffA);
            PG8_WAIT_V(8); PG8_WAIT_L(0); PG8_BAR; PG8_MMA(0, 0, At, B0); PG8_MMA(0, 1, At, B1); PG8_BAR; PG8_SCHED;
            PG8_LDA(At, 0, 1); PG8_STAGE(PG8_SB(0, 0), b2, voffB); PG8_STAGE(PG8_SB(0, 1), b2 + hstep, voffB); PG8_STAGE(PG8_SA(0, 0), a2, voffA);
            PG8_WAIT_V(8); PG8_WAIT_L(0); PG8_BAR; PG8_MMA(1, 0, At, B0); PG8_MMA(1, 1, At, B1); PG8_BAR; PG8_SCHED;
            PG8_LDB(B0, 1, 0); PG8_LDB(B1, 1, 1); PG8_SCHED; PG8_LDA(At, 1, 0); PG8_STAGE(PG8_SA(0, 1), a2 + hstep, voffA);
            PG8_WAIT_V(8); PG8_WAIT_L(0); PG8_BAR; PG8_MMA(0, 0, At, B0); PG8_MMA(0, 1, At, B1); PG8_BAR; PG8_SCHED;
            PG8_LDA(At, 1, 1); PG8_STAGE(PG8_SB(1, 0), b3, voffB); PG8_STAGE(PG8_SB(1, 1), b3 + hstep, voffB); PG8_STAGE(PG8_SA(1, 0), a3, voffA);
            PG8_WAIT_V(8); PG8_WAIT_L(0); PG8_BAR; PG8_MMA(1, 0, At, B0); PG8_MMA(1, 1, At, B1); PG8_BAR; PG8_SCHED;
            } else {
            PG8_LDB(B0, 0, 0); PG8_SCHED; PG8_LDA(At, 0, 0); PG8_STAGE(PG8_SA(1, 1), a1 + hstep, voffA);
            PG8_WAIT_L(8); PG8_BAR; PG8_WAIT_L(0); PG8_MMA(0, 0, At, B0); PG8_BAR; PG8_SCHED;
            PG8_LDB(B1, 0, 1); PG8_STAGE(PG8_SB(0, 0), b2, voffB);
            PG8_BAR; PG8_WAIT_L(0); PG8_MMA(0, 1, At, B1); PG8_BAR;
            PG8_LDA(At, 0, 1); PG8_STAGE(PG8_SA(0, 0), a2, voffA);
            PG8_BAR; PG8_WAIT_L(0); PG8_MMA(1, 0, At, B0); PG8_BAR; PG8_SCHED;
            PG8_STAGE(PG8_SB(0, 1), b2 + hstep, voffB);
            PG8_WAIT_V(6); PG8_BAR; PG8_MMA(1, 1, At, B1); PG8_BAR;
            PG8_LDB(B0, 1, 0); PG8_SCHED; PG8_LDA(At, 1, 0); PG8_STAGE(PG8_SA(0, 1), a2 + hstep, voffA);
            PG8_WAIT_L(8); PG8_BAR; PG8_WAIT_L(0); PG8_MMA(0, 0, At, B0); PG8_BAR; PG8_SCHED;
            PG8_LDB(B1, 1, 1); PG8_STAGE(PG8_SB(1, 0), b3, voffB);
            PG8_BAR; PG8_WAIT_L(0); PG8_MMA(0, 1, At, B1); PG8_BAR;
            PG8_LDA(At, 1, 1); PG8_STAGE(PG8_SA(1, 0), a3, voffA);
            PG8_BAR; PG8_WAIT_L(0); PG8_MMA(1, 0, At, B0); PG8_BAR; PG8_SCHED;
            PG8_STAGE(PG8_SB(1, 1), b3 + hstep, voffB);
            PG8_WAIT_V(6); PG8_BAR; PG8_MMA(1, 1, At, B1); PG8_BAR;
            }
        }
        if constexpr (ALIGN_EPI) { if (wr == 0) PG8_BAR; }
        if constexpr (!Epi::AFTER_DRAIN) { E(acc, cur, wr, wc, fr, fq); S.done(cur); }
        if (!has_next) break;
#pragma unroll
        for (int a = 0; a < 2; ++a)
#pragma unroll
            for (int b = 0; b < 2; ++b)
#pragma unroll
                for (int m = 0; m < 4; ++m)
#pragma unroll
                    for (int n = 0; n < 2; ++n) acc[a][b][m][n] = (f32x4){0.f, 0.f, 0.f, 0.f};
        cur = nxt; cA = nA; cB = nB; ++ui;
        if constexpr (ALIGN_EPI) { if (wr == 1) PG8_BAR; }
    }
    PG8_WAIT_V(0);
    if constexpr (!ALIGN_EPI) { if (wr == 0) PG8_BAR; }
    PG8_BAR;
    if constexpr (Epi::AFTER_DRAIN) { E.fused(acc, cur, wr, wc, fr, fq, lds, wid, lane); S.done(cur); }
#undef PG8_SA
#undef PG8_SB
#undef PG8_STAGE
#undef PG8_LDA
#undef PG8_LDB
#undef PG8_MMA
#undef PG8_WAIT_V
#undef PG8_WAIT_L
#undef PG8_BAR
#undef PG8_SCHED
}
}

#ifndef PG8_SP2
#define PG8_SP2 true
#endif
#ifndef PG8_ALIGN
#define PG8_ALIGN true
#endif
namespace attn_body {
using bf16=__hip_bfloat16;
using bf16x8=__attribute__((ext_vector_type(8)))short;
using s16x4=__attribute__((ext_vector_type(4)))short;
using f32x16=__attribute__((ext_vector_type(16)))float;
using u32x4=__attribute__((ext_vector_type(4)))unsigned;
constexpr int BATCH=2,NHEAD=8,NKV=2,SEQ=16384,D=64,QP=512,KP=256,OP=1024,GP=2048;
constexpr int NW=8,QBLK=32,QB=QBLK*NW,KVBLK=64,NQB=SEQ/QB;
constexpr int ATTN_UNIT_ROWS=QB;
__device__ __forceinline__ int crow(int r,int hi){return (r&3)+8*(r>>2)+4*hi;}
#define SBAR() __builtin_amdgcn_sched_barrier(0)
__device__ __forceinline__ void cmask(f32x16&p0,f32x16&p1,int jb,int qrel,int hi){
  const float NEG=-INFINITY; int kb=64*jb+4*hi;
  #pragma unroll
  for(int r=0;r<16;++r){int kv=kb+(r&3)+8*(r>>2); if(kv>qrel)p0[r]=NEG; if(kv+32>qrel)p1[r]=NEG;}
}

constexpr int NSLOT=3, SLOTB=8192;
constexpr int LDS_K=0, LDS_V=NSLOT*SLOTB, LDS_WS=2*NSLOT*SLOTB, LDS_OST=LDS_WS+NW*64*4, LDS_BYTES=LDS_OST+NW*4096;
constexpr float C2=0.125f*1.4426950408889634f;
__device__ __forceinline__ void glds16(const void*gsrc,unsigned lds_dst){unsigned keep;
  asm volatile("s_mov_b32 %0, m0\n\ts_mov_b32 m0, %2\n\ts_nop 0\n\tglobal_load_lds_dwordx4 %1, off\n\ts_mov_b32 m0, %0":"=&s"(keep):"v"(gsrc),"s"(lds_dst):"memory");}
__device__ __forceinline__ float max3f(float a,float b,float c){float r;asm("v_max3_f32 %0, %1, %2, %3":"=v"(r):"v"(a),"v"(b),"v"(c));return r;}
__device__ __forceinline__ float max2f(float a,float b){float r;asm("v_max_f32_e32 %0, %1, %2":"=v"(r):"v"(a),"v"(b));return r;}
__device__ __forceinline__ float fadd_s(float a,float b){float r;asm("v_add_f32_e32 %0, %1, %2":"=v"(r):"v"(a),"v"(b));return r;}
__device__ __forceinline__ float fsub_s(float a,float b){float r;asm("v_sub_f32_e32 %0, %1, %2":"=v"(r):"v"(a),"v"(b));return r;}
typedef float f32x2_t __attribute__((ext_vector_type(2))); typedef __bf16 bf16x2_t __attribute__((ext_vector_type(2)));
__device__ __forceinline__ unsigned cvtpk_s(float lo,float hi){f32x2_t v={lo,hi};bf16x2_t b=__builtin_convertvector(v,bf16x2_t);return __builtin_bit_cast(unsigned,b);}
#define WAIT_BAR(N) asm volatile("s_waitcnt vmcnt(" #N ") lgkmcnt(0)\n\ts_barrier":::"memory")

__device__ __forceinline__ void qkt(f32x16&p0,f32x16&p1,const char*Kslot,const bf16x8*qr,const f32x16&negm,int r32,int hi){
  const char*kb=Kslot+hi*1024+r32*16;
  #pragma unroll
  for(int d0=0;d0<4;++d0){
    const bf16x8 b0=*reinterpret_cast<const bf16x8*>(kb+d0*2048);
    const bf16x8 b1=*reinterpret_cast<const bf16x8*>(kb+d0*2048+512);
    if(d0==0){p0=__builtin_amdgcn_mfma_f32_32x32x16_bf16(b0,qr[0],negm,0,0,0);p1=__builtin_amdgcn_mfma_f32_32x32x16_bf16(b1,qr[0],negm,0,0,0);}
    else{p0=__builtin_amdgcn_mfma_f32_32x32x16_bf16(b0,qr[d0],p0,0,0,0);p1=__builtin_amdgcn_mfma_f32_32x32x16_bf16(b1,qr[d0],p1,0,0,0);}}
}
typedef __attribute__((address_space(3))) const char* lds_cptr;
typedef short v4i16_t __attribute__((ext_vector_type(4)));
__device__ __forceinline__ void kload8(bf16x8*kf,lds_cptr kp){
  kf[0]=*(const __attribute__((address_space(3))) bf16x8*)(kp);      kf[1]=*(const __attribute__((address_space(3))) bf16x8*)(kp+512);
  kf[2]=*(const __attribute__((address_space(3))) bf16x8*)(kp+2048); kf[3]=*(const __attribute__((address_space(3))) bf16x8*)(kp+2560);
  kf[4]=*(const __attribute__((address_space(3))) bf16x8*)(kp+4096); kf[5]=*(const __attribute__((address_space(3))) bf16x8*)(kp+4608);
  kf[6]=*(const __attribute__((address_space(3))) bf16x8*)(kp+6144); kf[7]=*(const __attribute__((address_space(3))) bf16x8*)(kp+6656);
}
__device__ __forceinline__ void kload2(bf16x8*kf,lds_cptr kp,int j){ kf[2*j]=*(const __attribute__((address_space(3))) bf16x8*)(kp+j*2048); kf[2*j+1]=*(const __attribute__((address_space(3))) bf16x8*)(kp+j*2048+512); }
__device__ __forceinline__ s16x4 vtr(lds_cptr p){ return __builtin_bit_cast(s16x4,__builtin_amdgcn_ds_read_tr16_b64_v4i16((__attribute__((address_space(3))) v4i16_t*)p)); }
__device__ __forceinline__ float rowmax(const f32x16&p0,const f32x16&p1){
  float a=max3f(p0[0],p0[1],p1[0]),b=max3f(p0[2],p0[3],p1[1]);a=max3f(a,p1[2],p1[3]);
  #pragma unroll
  for(int r=4;r<16;r+=4){a=max3f(a,p0[r],p0[r+1]);b=max3f(b,p0[r+2],p0[r+3]);a=max3f(a,p1[r],p1[r+1]);b=max3f(b,p1[r+2],p1[r+3]);}
  const float m=max2f(a,b);
  auto rr=__builtin_amdgcn_permlane32_swap(__float_as_uint(m),__float_as_uint(m),false,false);
  return max2f(__uint_as_float(rr[0]),__uint_as_float(rr[1]));
}
__device__ __forceinline__ void pv(f32x16*o,int vb,bf16x8 pa0,bf16x8 pa1,bf16x8 pa2,bf16x8 pa3){
  #pragma unroll
  for(int d0=0;d0<2;++d0){s16x4 lo[4],hi[4];
    #pragma unroll
    for(int ks=0;ks<4;++ks){
      asm volatile("ds_read_b64_tr_b16 %0,%1 offset:%c2":"=&v"(lo[ks]):"v"(vb),"i"(d0*4096+ks*1024):"memory");
      asm volatile("ds_read_b64_tr_b16 %0,%1 offset:%c2":"=&v"(hi[ks]):"v"(vb),"i"(d0*4096+ks*1024+512):"memory");}
    asm volatile("s_waitcnt lgkmcnt(0)":::"memory");SBAR();
    #define PK(k) (bf16x8){lo[k][0],lo[k][1],lo[k][2],lo[k][3],hi[k][0],hi[k][1],hi[k][2],hi[k][3]}
    o[d0]=__builtin_amdgcn_mfma_f32_32x32x16_bf16(pa0,PK(0),o[d0],0,0,0);
    o[d0]=__builtin_amdgcn_mfma_f32_32x32x16_bf16(pa1,PK(1),o[d0],0,0,0);
    o[d0]=__builtin_amdgcn_mfma_f32_32x32x16_bf16(pa2,PK(2),o[d0],0,0,0);
    o[d0]=__builtin_amdgcn_mfma_f32_32x32x16_bf16(pa3,PK(3),o[d0],0,0,0);
    #undef PK
  }
}

#ifndef ATTN_STORE16
#define ATTN_STORE16(p,v) (*(u32x4*)(p)=(v))
#endif
template<int THRL> __device__ __forceinline__ void attn_unit(int b,int h,int qb,const bf16*Q,const bf16*__restrict__ K,const bf16*__restrict__ V,bf16*O,const bf16*__restrict__ G,float cshift,char*shm){
  int tid_l=threadIdx.x; asm volatile("":"+v"(tid_l)); const int tid=tid_l,lane=tid&63,r32=lane&31,hi=lane>>5; const int wid=__builtin_amdgcn_readfirstlane(tid>>6);
  const long rowbase=(long)b*SEQ; const int q0=qb*QB;
  const bf16*Qw=Q+(rowbase+q0+wid*QBLK)*QP+h*D; const int kvh=h/(NHEAD/NKV);
  const bf16*Kh=K+rowbase*KP+kvh*D,*Vh=V+rowbase*KP+kvh*D;
  const unsigned lds0=(unsigned)(uintptr_t)shm;
  float*wsf=(float*)(shm+LDS_WS)+wid*64;
  const bf16*ksrc=Kh+(long)lane*KP+wid*8;
  const bf16*vsrc=Vh+(long)(16*(wid&3)+(lane>>2))*KP+(wid>>2)*32+(lane&3)*8;
  const unsigned kdst=lds0+LDS_K+wid*1024, vdst=lds0+LDS_V+wid*1024;
  #define DMA_K(t,slot) glds16(ksrc+(long)(t)*KVBLK*KP,(unsigned)__builtin_amdgcn_readfirstlane(kdst+(slot)))
  #define DMA_V(t,slot) glds16(vsrc+(long)(t)*KVBLK*KP,(unsigned)__builtin_amdgcn_readfirstlane(vdst+(slot)))
  const int vb0=(int)(lds0+LDS_V)+((lane>>4)&1)*32+(lane&3)*8+(4*hi+((lane&15)>>2))*64;
  const char*Kbase=shm+LDS_K; bf16x8 kf[8];
  const lds_cptr shm3=(lds_cptr)shm; const lds_cptr kp0=shm3+LDS_K+hi*1024+r32*16; const lds_cptr vp0=shm3+LDS_V+((lane>>4)&1)*32+(lane&3)*8+(4*hi+((lane&15)>>2))*64;
  const int NT=SEQ/KVBLK;
  DMA_K(0,0);DMA_V(0,0);DMA_K(1,SLOTB);
  bf16x8 qr[4];
  #pragma unroll
  for(int d0=0;d0<4;++d0)qr[d0]=*reinterpret_cast<const bf16x8*>(&Qw[(long)r32*QP+d0*16+hi*8]);
  float l_reg=0.f;f32x16 o[2];o[0]=f32x16{};o[1]=f32x16{};f32x16 negm;
  _Pragma("unroll") for(int r=0;r<16;++r)negm[r]=-cshift;
  asm volatile("":"+v"(negm));
  const int qrel=wid*QBLK+r32;
  #define CMASK(P0,P1,t) do{}while(0)
  bool resc=false;
  #define START(P0,P1) do{ const float rm=rowmax(P0,P1); resc=false; \
    { const float dl=rm; mhat=fadd_s(mhat,dl); \
      _Pragma("unroll") for(int r=0;r<16;++r){P0[r]=fsub_s(P0[r],dl);P1[r]=fsub_s(P1[r],dl);} \
      _Pragma("unroll") for(int r=0;r<16;++r)negm[r]=-mhat; asm volatile("":"+v"(negm)); } \
    _Pragma("unroll") for(int r=0;r<16;++r)P0[r]=__builtin_amdgcn_exp2f(P0[r]); }while(0)
  #define RESC() do{ if(resc){ asm volatile("s_waitcnt lgkmcnt(0)":::"memory"); \
      _Pragma("unroll") for(int d_=0;d_<2;++d_) _Pragma("unroll") for(int r=0;r<16;++r)o[d_][r]*=wsf[crow(r,hi)]; } }while(0)
  f32x16 pA0,pA1,pB0,pB1;
  int sl_prev=0,sl_cur=0,sl_next=SLOTB;
  #define ROT() do{sl_prev=sl_cur;sl_cur=sl_next;sl_next=(sl_next==(NSLOT-1)*SLOTB)?0:sl_next+SLOTB;}while(0)
  DMA_K(2,2*SLOTB);
  WAIT_BAR(3);
  qkt(pA0,pA1,Kbase,qr,negm,r32,hi);asm volatile("s_nop 15\n\ts_nop 7":"+v"(pA0),"+v"(pA1));CMASK(pA0,pA1,0);
  _Pragma("unroll") for(int r=0;r<16;++r)pA0[r]=__builtin_amdgcn_exp2f(pA0[r]);
  _Pragma("unroll") for(int r=0;r<16;++r)pA1[r]=__builtin_amdgcn_exp2f(pA1[r]);
  WAIT_BAR(0);
  DMA_K(3,0);DMA_V(1,SLOTB);
  ROT();
  kload8(kf,kp0+sl_cur);
  WAIT_BAR(2);
  s16x4 vlo[8],vhi[8]; u32x4 pw0,pw1,pw2,pw3;
  #define PKW(P,B) cvtpk_s(P[B],P[B+1])
  #define PAF(k) __builtin_bit_cast(bf16x8,pw##k)
  #define VFR(i) (bf16x8){vlo[i][0],vlo[i][1],vlo[i][2],vlo[i][3],vhi[i][0],vhi[i][1],vhi[i][2],vhi[i][3]}
  #define PIN(x) asm volatile("":"+v"(x))
  #define MX3(a,b,c) __builtin_fmaxf(__builtin_fmaxf((a),(b)),(c))
  #define GAPA(MF,A0,A1,A2,A3,W0,W1,PW) do{ __builtin_amdgcn_s_setprio(1); MF; __builtin_amdgcn_s_setprio(0); sacc+=A0; sacc+=A1; sacc+=A2; sacc+=A3; PIN(sacc); W0; W1; PIN(PW); SBAR(); }while(0)
  #define EX(v) __builtin_amdgcn_exp2f(v)
  #define GAPB(MF,X,B) do{ MF; X[B]=EX(X[B]); X[B+1]=EX(X[B+1]); X[B+2]=EX(X[B+2]); X[B+3]=EX(X[B+3]); PIN(X); SBAR(); }while(0)
  #define VRD(i) do{ vlo[i]=vtr(vp_+(((i)>>2)*4096+((i)&3)*1024)); vhi[i]=vtr(vp_+(((i)>>2)*4096+((i)&3)*1024+512)); }while(0)
  #define KRD(G,j) do{ if(G){ kload2(kf,kp0+sl_next,j); SBAR(); } }while(0)
  #define STEP(C0,C1,P0,P1,t,GK,GV,GL) do{ SBAR(); \
    const lds_cptr vp_=vp0+sl_prev; \
    VRD(0); SBAR(); float sacc=(P0[0]+P0[1]); \
    GAPA(C0=__builtin_amdgcn_mfma_f32_32x32x16_bf16(kf[0],qr[0],negm,0,0,0), P0[2],P0[3],P0[4],P0[5],     pw0[0]=PKW(P0,0), pw0[1]=PKW(P0,2), pw0); \
    VRD(4); SBAR(); GAPA(C1=__builtin_amdgcn_mfma_f32_32x32x16_bf16(kf[1],qr[0],negm,0,0,0), P0[6],P0[7],P0[8],P0[9],     pw0[2]=PKW(P0,4), pw0[3]=PKW(P0,6), pw0); \
    VRD(1); SBAR(); GAPA(C0=__builtin_amdgcn_mfma_f32_32x32x16_bf16(kf[2],qr[1],C0,0,0,0),   P0[10],P0[11],P0[12],P0[13], pw1[0]=PKW(P0,8), pw1[1]=PKW(P0,10), pw1); \
    VRD(5); SBAR(); GAPA(C1=__builtin_amdgcn_mfma_f32_32x32x16_bf16(kf[3],qr[1],C1,0,0,0),   P0[14],P0[15],P1[0],P1[1],   pw1[2]=PKW(P0,12),pw1[3]=PKW(P0,14), pw1); \
    VRD(2); SBAR(); GAPA(C0=__builtin_amdgcn_mfma_f32_32x32x16_bf16(kf[4],qr[2],C0,0,0,0),   P1[2],P1[3],P1[4],P1[5],     pw2[0]=PKW(P1,0), pw2[1]=PKW(P1,2), pw2); \
    VRD(6); SBAR(); GAPA(C1=__builtin_amdgcn_mfma_f32_32x32x16_bf16(kf[5],qr[2],C1,0,0,0),   P1[6],P1[7],P1[8],P1[9],     pw2[2]=PKW(P1,4), pw2[3]=PKW(P1,6), pw2); \
    VRD(3); SBAR(); GAPA(C0=__builtin_amdgcn_mfma_f32_32x32x16_bf16(kf[6],qr[3],C0,0,0,0),   P1[10],P1[11],P1[12],P1[13], pw3[0]=PKW(P1,8), pw3[1]=PKW(P1,10), pw3); \
    VRD(7); SBAR(); GAPA(C1=__builtin_amdgcn_mfma_f32_32x32x16_bf16(kf[7],qr[3],C1,0,0,0),   P1[14],P1[15],0.f,0.f,       pw3[2]=PKW(P1,12),pw3[3]=PKW(P1,14), pw3); \
    l_reg+=sacc; \
    if(GK){DMA_K((t)+3,sl_cur);} if(GV){DMA_V((t)+1,sl_next);} \
    SBAR(); \
    GAPB(o[0]=__builtin_amdgcn_mfma_f32_32x32x16_bf16(PAF(0),VFR(0),o[0],0,0,0), C0,0); \
    GAPB(o[1]=__builtin_amdgcn_mfma_f32_32x32x16_bf16(PAF(0),VFR(4),o[1],0,0,0), C0,4); \
    KRD(GL,0); GAPB(o[0]=__builtin_amdgcn_mfma_f32_32x32x16_bf16(PAF(1),VFR(1),o[0],0,0,0), C0,8); \
    KRD(GL,1); GAPB(o[1]=__builtin_amdgcn_mfma_f32_32x32x16_bf16(PAF(1),VFR(5),o[1],0,0,0), C0,12); \
    KRD(GL,2); GAPB(o[0]=__builtin_amdgcn_mfma_f32_32x32x16_bf16(PAF(2),VFR(2),o[0],0,0,0), C1,0); \
    KRD(GL,3); GAPB(o[1]=__builtin_amdgcn_mfma_f32_32x32x16_bf16(PAF(2),VFR(6),o[1],0,0,0), C1,4); \
    GAPB(o[0]=__builtin_amdgcn_mfma_f32_32x32x16_bf16(PAF(3),VFR(3),o[0],0,0,0), C1,8); \
    GAPB(o[1]=__builtin_amdgcn_mfma_f32_32x32x16_bf16(PAF(3),VFR(7),o[1],0,0,0), C1,12); \
    }while(0)
  int t=1;
  #undef CMASK
  #define CMASK(P0,P1,t) do{}while(0)
  for(;t+5<NT;t+=2){
    STEP(pB0,pB1,pA0,pA1,t,true,true,true);     WAIT_BAR(2); ROT();
    STEP(pA0,pA1,pB0,pB1,t+1,true,true,true);   WAIT_BAR(2); ROT();
  }
  #undef CMASK
  #define CMASK(P0,P1,t) do{}while(0)
  #define ENDW(tt) do{ if((tt)+3<NT){WAIT_BAR(2);} else if((tt)+2<NT){WAIT_BAR(1);} else {WAIT_BAR(0);} }while(0)
  for(;t+1<NT;t+=2){
    STEP(pB0,pB1,pA0,pA1,t,(t+3<NT),(t+1<NT),(t+1<NT));       ENDW(t);   ROT();
    STEP(pA0,pA1,pB0,pB1,t+1,(t+4<NT),(t+2<NT),(t+2<NT));     ENDW(t+1); ROT();
  }
  STEP(pB0,pB1,pA0,pA1,NT-1,false,false,false);
  { float sacc=pB0[0]+pB0[1]; _Pragma("unroll") for(int r=2;r<16;++r)sacc+=pB0[r]; _Pragma("unroll") for(int r=0;r<16;++r)sacc+=pB1[r]; l_reg+=sacc;
    pw0=(u32x4){PKW(pB0,0),PKW(pB0,2),PKW(pB0,4),PKW(pB0,6)};pw1=(u32x4){PKW(pB0,8),PKW(pB0,10),PKW(pB0,12),PKW(pB0,14)};pw2=(u32x4){PKW(pB1,0),PKW(pB1,2),PKW(pB1,4),PKW(pB1,6)};pw3=(u32x4){PKW(pB1,8),PKW(pB1,10),PKW(pB1,12),PKW(pB1,14)};
    SBAR(); pv(o,vb0+sl_cur,PAF(0),PAF(1),PAF(2),PAF(3)); }
  #undef PKW
  #undef PAF
  #undef VFR
  #undef PIN
  #undef MX3
  #undef GAPA
  #undef GAPB
  #undef EX
  #undef VRD
  #undef KRD
  #undef STEP
  #undef ENDW
  {auto rr=__builtin_amdgcn_permlane32_swap(__float_as_uint(l_reg),__float_as_uint(l_reg),false,false);l_reg=__uint_as_float(rr[0])+__uint_as_float(rr[1]);}
  if(hi==0)wsf[32+r32]=l_reg;asm volatile("s_waitcnt lgkmcnt(0)":::"memory");
  float rli[16];
  #pragma unroll
  for(int r=0;r<16;++r)rli[r]=__builtin_amdgcn_rcpf(wsf[32+crow(r,hi)]);
  bf16*Ow=O+(rowbase+q0+wid*QBLK)*OP+h*D; const bf16*Gw=G+(rowbase+q0+wid*QBLK)*GP+h*D;
  { bf16*stg=(bf16*)(shm+LDS_OST)+wid*2048;
    #pragma unroll
    for(int r=0;r<16;++r){const int orow=crow(r,hi);
      #pragma unroll
      for(int d0=0;d0<2;++d0)stg[orow*64+d0*32+r32]=__float2bfloat16(o[d0][r]*rli[r]);}
    asm volatile("s_waitcnt lgkmcnt(0)":::"memory");
    #pragma unroll
    for(int i=0;i<4;++i){const int row=i*8+(lane>>3),ch=lane&7; u32x4 v=*(const u32x4*)(stg+row*64+ch*8); const u32x4 g=*(const u32x4*)(Gw+(long)row*GP+ch*8);
      _Pragma("unroll") for(int j=0;j<4;++j){ const float o0=__uint_as_float(v[j]<<16),o1=__uint_as_float(v[j]&0xffff0000u),g0=__uint_as_float(g[j]<<16),g1=__uint_as_float(g[j]&0xffff0000u);
        const float s0=g0*__builtin_amdgcn_rcpf(1.f+__builtin_amdgcn_exp2f(-1.4426950408889634f*g0)),s1=g1*__builtin_amdgcn_rcpf(1.f+__builtin_amdgcn_exp2f(-1.4426950408889634f*g1)); v[j]=cvtpk_s(o0*s0,o1*s1);}
      ATTN_STORE16(Ow+(long)row*OP+ch*8,v);} }
  asm volatile("s_waitcnt lgkmcnt(0)\n\ts_barrier":::"memory");
  #undef DMA_K
  #undef DMA_V
  #undef CMASK
  #undef START
  #undef RESC
  #undef ROT
}
constexpr int ATTN_LDS_BYTES=LDS_BYTES;
struct AttnTensors { const bf16* Q; const bf16* K; const bf16* V; bf16* O; const bf16* G; float cshift; };
struct AttnUnit { int bh; int qb; };
struct StaticOrder {
  int vcu,G;
  __device__ __forceinline__ explicit StaticOrder(int grid,int block):vcu((grid%8==0)?(block%8)*(grid/8)+block/8:block),G(grid){}
  __device__ __forceinline__ bool next(int i,AttnUnit&u)const{ const int NU=BATCH*NHEAD*NQB; const int per=(NU+G-1)/G; if(i>=per)return false; const int id=vcu*per+i; if(id>=NU)return false; u.bh=id/NQB; u.qb=id%NQB; return true; }
  __device__ __forceinline__ void a_ready(const AttnUnit&)const{}
  __device__ __forceinline__ void done(const AttnUnit&)const{}
};
template<class Sched,int THRL=8> __device__ __forceinline__ void attn_phase(char*lds,const AttnTensors&T,const Sched&S){
  AttnUnit u;
  for(int i=0;S.next(i,u);++i){ S.a_ready(u); attn_unit<THRL>(u.bh/NHEAD,u.bh%NHEAD,u.qb,T.Q,T.K,T.V,T.O,T.G,T.cshift,lds); S.done(u); }
}
#undef SBAR
#undef WAIT_BAR
}
#ifndef MK_SPLIT
#define MK_SPLIT 0
#endif
constexpr int NWAVES = 8;
constexpr int BATCH = 2, SEQ = 16384, DMODEL = 1024, M = BATCH * SEQ, DIN = 2816, DEPTH = 2;
constexpr float EPS = 1e-6f;
constexpr int NPHASE = 1 + 5 * DEPTH;
constexpr size_t MiB = 1u << 20;
constexpr size_t WS_TAB = 0;
constexpr size_t WS_CTL = 512 * 1024, CTL_ZERO_BYTES = 16384;
constexpr size_t WS_WIN = 1 * MiB;
constexpr size_t WS_WOUT = 12 * MiB;
constexpr size_t WS_XN = 16 * MiB;
constexpr size_t WS_Q = 80 * MiB;
constexpr size_t WS_KV = 112 * MiB;
constexpr size_t WS_R = 128 * MiB;
constexpr size_t WS_MO = 256 * MiB;
constexpr size_t WS_GS = 320 * MiB;
constexpr size_t WS_END = 352 * MiB;
constexpr int LDS_BYTES = 147456;
constexpr int MISC_OFF = 131072 + 320;

#define LAS __attribute__((address_space(3)))
typedef unsigned short bf16;
typedef unsigned u32x4 __attribute__((ext_vector_type(4)));
typedef unsigned u32x2 __attribute__((ext_vector_type(2)));
typedef float f32x4 __attribute__((ext_vector_type(4)));
typedef float f32x2 __attribute__((ext_vector_type(2)));
typedef float f32x16 __attribute__((ext_vector_type(16)));
typedef short bf16x8 __attribute__((ext_vector_type(8)));

__device__ __forceinline__ float bflo(unsigned v) { return __uint_as_float(v << 16); }
__device__ __forceinline__ float bfhi(unsigned v) { return __uint_as_float(v & 0xffff0000u); }
__device__ __forceinline__ float bf1(unsigned short v) { return __uint_as_float(((unsigned)v) << 16); }
__device__ __forceinline__ unsigned pk2(float lo, float hi) { return pg8::cvt_pk_bf16(lo, hi); }
__device__ __forceinline__ float sigmoid_(float x) { return __builtin_amdgcn_rcpf(1.f + __builtin_amdgcn_exp2f(-1.4426950408889634f * x)); }
__device__ __forceinline__ float silu_(float x) { return x * sigmoid_(x); }
__device__ __forceinline__ float gelu_(float v) {
    const float av = __builtin_fabsf(v), t = __builtin_amdgcn_rcpf(av * 0.2316418882f + 1.0f);
    float q = t * 0.5307027145f + (-0.7265760135f); q = q * t + 0.7107068705f; q = q * t + (-0.142248368f); q = q * t + 0.127414796f; q = q * t;
    const float e = __builtin_amdgcn_exp2f((v * v) * (-0.72134752044f));
    const float m = v * (q * e);
    return v < 0.f ? m : v - m;
}
__device__ __forceinline__ float wave_sum(float v) {
#pragma unroll
    for (int o = 1; o < 64; o <<= 1) v += __shfl_xor(v, o);
    return v;
}
__device__ __forceinline__ int crow_(int r, int hi) { return (r & 3) + 8 * (r >> 2) + 4 * hi; }

__device__ __forceinline__ void p0_transpose_item(const float* W, int K, int N, bf16* WT, LAS float* scr, int item, int lane) {
    const int nblk = N / 32, kb = item / nblk, nb = item % nblk, k0 = 64 * kb, n0 = 32 * nb;
#pragma unroll 8
    for (int i = 0; i < 32; ++i) { const int kk = 2 * i + (lane >> 5); scr[kk * 33 + (lane & 31)] = __builtin_nontemporal_load(W + (size_t)(k0 + kk) * N + n0 + (lane & 31)); }
    asm volatile("s_waitcnt lgkmcnt(0)" ::: "memory");
    const int c = lane & 7;
#pragma unroll
    for (int j = 0; j < 4; ++j) { const int n = (lane >> 3) + 8 * j; const LAS float* s = scr + (8 * c) * 33 + n;
        u32x4 o; o.x = pk2(s[0 * 33], s[1 * 33]); o.y = pk2(s[2 * 33], s[3 * 33]); o.z = pk2(s[4 * 33], s[5 * 33]); o.w = pk2(s[6 * 33], s[7 * 33]);
        *(u32x4*)(WT + (size_t)(n0 + n) * K + k0 + 8 * c) = o; }
    asm volatile("s_waitcnt lgkmcnt(0)" ::: "memory");
}

constexpr int NR = 4;
__device__ __forceinline__ void norm_phase(int mode, const float* xin, const bf16* mo, const float* gpost, const float* gpre, float* xout, bf16* xn, int gw, int NGW, int lane_in) {
    int lane = lane_in; asm volatile("" : "+v"(lane));
    for (int m0 = gw; m0 < M; m0 += NR * NGW) {
        f32x4 x[NR][4]; u32x2 yw[NR][4];
#pragma unroll
        for (int k = 0; k < NR; ++k) { const size_t m = (size_t)(m0 + k * NGW);
#pragma unroll
            for (int j = 0; j < 4; ++j) x[k][j] = __builtin_nontemporal_load((const f32x4*)(xin + m * DMODEL + 4 * lane + 256 * j));
            if (mode >= 1) {
#pragma unroll
                for (int j = 0; j < 4; ++j) yw[k][j] = __builtin_nontemporal_load((const u32x2*)(mo + m * DMODEL + 4 * lane + 256 * j)); } }
#pragma unroll
        for (int k = 0; k < NR; ++k) { const size_t m = (size_t)(m0 + k * NGW);
            if (mode >= 1) {
                f32x4 y[4]; float ss = 0.f;
#pragma unroll
                for (int j = 0; j < 4; ++j) { const u32x2 w = yw[k][j]; y[j] = (f32x4){bflo(w.x), bfhi(w.x), bflo(w.y), bfhi(w.y)};
                    ss += (y[j].x * y[j].x + y[j].y * y[j].y) + (y[j].z * y[j].z + y[j].w * y[j].w); }
                const float r = 1.0f / sqrtf(wave_sum(ss) * (1.f / DMODEL) + EPS);
#pragma unroll
                for (int j = 0; j < 4; ++j) { const f32x4 g = *(const f32x4*)(gpost + 4 * lane + 256 * j); x[k][j] = x[k][j] + y[j] * r * g;
                    __builtin_nontemporal_store(x[k][j], (f32x4*)(xout + m * DMODEL + 4 * lane + 256 * j)); }
            }
            if (mode <= 1) {
                float ss = 0.f;
#pragma unroll
                for (int j = 0; j < 4; ++j) ss += (x[k][j].x * x[k][j].x + x[k][j].y * x[k][j].y) + (x[k][j].z * x[k][j].z + x[k][j].w * x[k][j].w);
                const float r = 1.0f / sqrtf(wave_sum(ss) * (1.f / DMODEL) + EPS);
#pragma unroll
                for (int j = 0; j < 4; ++j) { const f32x4 g = *(const f32x4*)(gpre + 4 * lane + 256 * j); const f32x4 v = x[k][j] * r * g;
                    u32x2 w; w.x = pk2(v.x, v.y); w.y = pk2(v.z, v.w); *(u32x2*)(xn + m * DMODEL + 4 * lane + 256 * j) = w; }
            }
        }
    }
}

struct ChunkParams { bf16* Q; bf16* KV; const bf16* GS; const bf16* R; bf16* MIX; const f32x2* tab; const float *q_norm, *k_norm, *conv_dw, *conv_dw_b, *conv_ln_g, *conv_ln_b, *sg_ln_g, *sg_ln_b, *sg_w, *sg_b; };
__device__ __forceinline__ void chunk_phase(LAS unsigned char* lds, const ChunkParams& P, int vcu, int G, int tid_in) {
    int tid = tid_in; asm volatile("" : "+v"(tid));
    int lane = tid & 63, wave = __builtin_amdgcn_readfirstlane(tid >> 6);
#define RELAUNDER() do { asm volatile("" : "+v"(tid)); lane = tid & 63; wave = __builtin_amdgcn_readfirstlane(tid >> 6); } while (0)
    for (int ch = vcu; ch < M / 128; ch += G) {
        RELAUNDER();
        const int row0 = ch * 128, t0 = (ch % (SEQ / 128)) * 128;
        LAS unsigned short* glu = (LAS unsigned short*)lds;
        LAS float* wl = (LAS float*)(lds + 81920);
        LAS f32x2* tabl = (LAS f32x2*)(lds + 116736);
        {
            f32x2 tv[3]; f32x4 wv[4];
#pragma unroll
            for (int k = 0; k < 3; ++k) { const int it = tid + 512 * k; const int e = it >> 4, i = it & 15; const int pos = e < 2 ? (t0 >> 6) + e : e - 2; tv[k] = (it < 66 * 16) ? P.tab[pos * 16 + i] : (f32x2){0.f, 0.f}; }
#pragma unroll
            for (int k = 0; k < 4; ++k) { const int it = tid + 512 * k; wv[k] = (it < 31 * 64) ? ((const f32x4*)P.conv_dw)[it] : (f32x4){0.f, 0.f, 0.f, 0.f}; }
#pragma unroll
            for (int k = 0; k < 3; ++k) { const int it = tid + 512 * k; if (it < 66 * 16) tabl[it] = tv[k]; }
#pragma unroll
            for (int k = 0; k < 4; ++k) { const int it = tid + 512 * k; if (it < 31 * 64) ((LAS f32x4*)wl)[it] = wv[k]; }
        }
        __syncthreads();
        RELAUNDER();
        {
          for (int kb = 0; kb < 6; kb += 2) {
            u32x4 raw[2][4];
#pragma unroll
            for (int k = 0; k < 2; ++k) { const int id = tid + 512 * (kb + k); if (id >= 2560) continue; const int vec = id >> 1, half = id & 1, tok = vec / 10, hh = vec - tok * 10;
                const bf16* p = (hh < 8) ? P.Q + (size_t)(row0 + tok) * 512 + hh * 64 + half * 32 : P.KV + (size_t)(row0 + tok) * 256 + (hh - 8) * 64 + half * 32;
#pragma unroll
                for (int j = 0; j < 4; ++j) raw[k][j] = ((const u32x4*)p)[j]; }
#pragma unroll
            for (int k = 0; k < 2; ++k) { const int id = tid + 512 * (kb + k); if (id >= 2560) continue; const int vec = id >> 1, half = id & 1, tok = vec / 10, hh = vec - tok * 10;
                bf16* p = (hh < 8) ? P.Q + (size_t)(row0 + tok) * 512 + hh * 64 + half * 32 : P.KV + (size_t)(row0 + tok) * 256 + (hh - 8) * 64 + half * 32;
                const float* gn = ((hh < 8) ? P.q_norm : P.k_norm) + half * 32;
                float x[32];
#pragma unroll
                for (int j = 0; j < 4; ++j)
#pragma unroll
                    for (int i = 0; i < 4; ++i) { x[8 * j + 2 * i] = bflo(raw[k][j][i]); x[8 * j + 2 * i + 1] = bfhi(raw[k][j][i]); }
                float ss = 0.f;
#pragma unroll
                for (int i = 0; i < 32; ++i) ss += x[i] * x[i];
                ss += __shfl_xor(ss, 1);
                const float rinv = 1.0f / sqrtf(ss * (1.f / 64.f) + EPS);
                const LAS f32x2* tp = tabl + (half ? 2 + (tok & 63) : (tok >> 6)) * 16;
                const float sc = (hh < 8) ? attn_body::C2 : 1.f;
#pragma unroll
                for (int i = 0; i < 16; ++i) { const f32x2 cs = tp[i]; const float a = x[i] * rinv * gn[i], b = x[i + 16] * rinv * gn[i + 16];
                    x[i] = (a * cs.x - b * cs.y) * sc; x[i + 16] = (b * cs.x + a * cs.y) * sc; }
#pragma unroll
                for (int j = 0; j < 4; ++j) { u32x4 o;
#pragma unroll
                    for (int i = 0; i < 4; ++i) o[i] = pk2(x[8 * j + 2 * i], x[8 * j + 2 * i + 1]);
                    ((u32x4*)p)[j] = o; }
            }
          }
        }
        RELAUNDER();
        for (int kb = 0; kb < 12; kb += 4) {
            u32x4 a1[4], a2[4];
#pragma unroll
            for (int k = 0; k < 4; ++k) { const int it = tid + 512 * (kb + k); const int rr = it >> 5, c8 = it & 31; const int t = t0 - 15 + rr;
                a1[k] = a2[k] = (u32x4){0u, 0u, 0u, 0u};
                if (it < 158 * 32 && t >= 0 && t < SEQ) { const bf16* rp = P.R + (size_t)(row0 - 15 + rr) * 2048 + 512 + c8 * 8; a1[k] = __builtin_nontemporal_load((const u32x4*)rp); a2[k] = __builtin_nontemporal_load((const u32x4*)(rp + 256)); } }
#pragma unroll
            for (int k = 0; k < 4; ++k) { const int it = tid + 512 * (kb + k); const int rr = it >> 5, c8 = it & 31; u32x4 o;
#pragma unroll
                for (int j = 0; j < 4; ++j) o[j] = pk2(bflo(a1[k][j]) * sigmoid_(bflo(a2[k][j])), bfhi(a1[k][j]) * sigmoid_(bfhi(a2[k][j])));
                if (it < 158 * 32) *(LAS u32x4*)(glu + rr * 256 + c8 * 8) = o; }
        }
        __syncthreads();
        RELAUNDER();
        {
            const int c0 = 4 * lane;
            const f32x4 cb = *(const f32x4*)(P.conv_dw_b + c0), lg = *(const f32x4*)(P.conv_ln_g + c0), lb = *(const f32x4*)(P.conv_ln_b + c0);
            for (int blk = 0; blk < 4; ++blk) {
                const int p0 = wave * 16 + blk * 4;
                u32x2 gcv[4];
#pragma unroll
                for (int i = 0; i < 4; ++i) gcv[i] = __builtin_nontemporal_load((const u32x2*)(P.R + (size_t)(row0 + p0 + i) * 2048 + 1024 + c0));
                f32x4 o[4]; o[0] = o[1] = o[2] = o[3] = (f32x4){0.f, 0.f, 0.f, 0.f};
                f32x4 w0 = (f32x4){0.f, 0.f, 0.f, 0.f}, w1 = w0, w2 = w0, w3 = w0;
#pragma unroll
                for (int r = 0; r < 34; ++r) {
                    const u32x2 gr = *(const LAS u32x2*)(glu + (p0 + r) * 256 + c0);
                    const f32x4 g = (f32x4){bflo(gr.x), bfhi(gr.x), bflo(gr.y), bfhi(gr.y)};
                    w3 = w2; w2 = w1; w1 = w0; w0 = (r <= 30) ? *(const LAS f32x4*)(wl + r * 256 + c0) : (f32x4){0.f, 0.f, 0.f, 0.f};
                    o[0] += g * w0; o[1] += g * w1; o[2] += g * w2; o[3] += g * w3;
                    if ((r & 3) == 3) asm volatile("" ::: "memory");
                }
#pragma unroll
                for (int i = 0; i < 4; ++i) {
                    const f32x4 h = o[i] + cb;
                    const float mean = wave_sum((h.x + h.y) + (h.z + h.w)) * (1.f / 256.f);
                    const f32x4 d = h - mean;
                    const float var = wave_sum((d.x * d.x + d.y * d.y) + (d.z * d.z + d.w * d.w)) * (1.f / 256.f);
                    const f32x4 y = d * (1.0f / sqrtf(var + EPS)) * lg + lb;
                    const size_t row = (size_t)(row0 + p0 + i);
                    const u32x2 gc = gcv[i];
                    u32x2 w; w.x = pk2(silu_(y.x) * silu_(bflo(gc.x)), silu_(y.y) * silu_(bfhi(gc.x))); w.y = pk2(silu_(y.z) * silu_(bflo(gc.y)), silu_(y.w) * silu_(bfhi(gc.y)));
                    __builtin_nontemporal_store(w, (u32x2*)(P.MIX + row * 1024 + 512 + c0));
                }
            }
        }
        __syncthreads();
        RELAUNDER();
        LAS unsigned short* vT = (LAS unsigned short*)lds;
        {
            float lg[4], lb[4];
#pragma unroll
            for (int j = 0; j < 4; ++j) { lg[j] = P.sg_ln_g[lane + 64 * j]; lb[j] = P.sg_ln_b[lane + 64 * j]; }
            for (int i0 = 0; i0 < 16; i0 += 8) {
                unsigned short vv[8][4];
#pragma unroll
                for (int i = 0; i < 8; ++i) { const bf16* vr = P.R + (size_t)(row0 + wave * 16 + i0 + i) * 2048 + 1536 + lane;
#pragma unroll
                    for (int j = 0; j < 4; ++j) vv[i][j] = vr[64 * j]; }
#pragma unroll
                for (int i = 0; i < 8; ++i) { const int p = wave * 16 + i0 + i;
                    float v[4]; float s = 0.f;
#pragma unroll
                    for (int j = 0; j < 4; ++j) { v[j] = gelu_(bf1(vv[i][j])); s += v[j]; }
                    const float mean = wave_sum(s) * (1.f / 256.f); float q = 0.f;
#pragma unroll
                    for (int j = 0; j < 4; ++j) { v[j] -= mean; q += v[j] * v[j]; }
                    const float rstd = 1.0f / sqrtf(wave_sum(q) * (1.f / 256.f) + EPS);
#pragma unroll
                    for (int j = 0; j < 4; ++j) vT[(lane + 64 * j) * 136 + p] = (unsigned short)(pk2(v[j] * rstd * lg[j] + lb[j], 0.f) & 0xffffu);
                }
            }
        }
        __syncthreads();
        RELAUNDER();
        {
            const int hd = wave >> 1, ph = wave & 1, r32 = lane & 31, hi = lane >> 5;
            f32x16 acc[2][2];
#pragma unroll
            for (int a = 0; a < 2; ++a)
#pragma unroll
                for (int b = 0; b < 2; ++b)
#pragma unroll
                    for (int r = 0; r < 16; ++r) acc[a][b][r] = 0.f;
            const float* Wh = P.sg_w + (size_t)hd * 128 * 128;
#pragma unroll 2
            for (int kk = 0; kk < 8; ++kk) {
                bf16x8 a[2], b[2];
#pragma unroll
                for (int pi = 0; pi < 2; ++pi) { const float* wp = Wh + (size_t)(64 * ph + 32 * pi + r32) * 128 + 16 * kk + 8 * hi; const f32x4 x0 = *(const f32x4*)wp, x1 = *(const f32x4*)(wp + 4);
                    u32x4 pk; pk.x = pk2(x0.x, x0.y); pk.y = pk2(x0.z, x0.w); pk.z = pk2(x1.x, x1.y); pk.w = pk2(x1.z, x1.w); a[pi] = __builtin_bit_cast(bf16x8, pk); }
#pragma unroll
                for (int di = 0; di < 2; ++di) b[di] = *(const LAS bf16x8*)(vT + (64 * hd + 32 * di + r32) * 136 + 16 * kk + 8 * hi);
#pragma unroll
                for (int pi = 0; pi < 2; ++pi)
#pragma unroll
                    for (int di = 0; di < 2; ++di) acc[pi][di] = __builtin_amdgcn_mfma_f32_32x32x16_bf16(a[pi], b[di], acc[pi][di], 0, 0, 0);
            }
            __syncthreads();
            LAS float* stg = (LAS float*)(lds + wave * 16384);
#pragma unroll
            for (int pi = 0; pi < 2; ++pi)
#pragma unroll
                for (int r = 0; r < 16; ++r) { const int pl = 32 * pi + crow_(r, hi); const float bs = P.sg_b[hd * 128 + 64 * ph + pl];
#pragma unroll
                    for (int di = 0; di < 2; ++di) stg[pl * 64 + 32 * di + r32] = acc[pi][di][r] + bs; }
            asm volatile("s_waitcnt lgkmcnt(0)" ::: "memory");
#pragma unroll 1
            for (int ib = 0; ib < 8; ib += 4) {
                const int d0 = (lane & 7) * 8; u32x4 uu[4], gg[4], gh[4];
#pragma unroll
                for (int k = 0; k < 4; ++k) { const size_t row = (size_t)(row0 + 64 * ph + (ib + k) * 8 + (lane >> 3));
                    uu[k] = *(const u32x4*)(P.R + row * 2048 + 1280 + 64 * hd + d0); gg[k] = *(const u32x4*)(P.GS + row * 256 + 64 * hd + d0); gh[k] = *(const u32x4*)(P.GS + (size_t)M * 256 + row * 256 + 64 * hd + d0); }
#pragma unroll
                for (int k = 0; k < 4; ++k) { const int pl = (ib + k) * 8 + (lane >> 3); const size_t row = (size_t)(row0 + 64 * ph + pl);
                    const f32x4 m0 = *(const LAS f32x4*)(stg + pl * 64 + d0), m1 = *(const LAS f32x4*)(stg + pl * 64 + d0 + 4);
                    u32x4 o;
                    o[0] = pk2(gelu_(bflo(uu[k][0])) * m0[0] * silu_(bflo(gg[k][0]) + bflo(gh[k][0])), gelu_(bfhi(uu[k][0])) * m0[1] * silu_(bfhi(gg[k][0]) + bfhi(gh[k][0])));
                    o[1] = pk2(gelu_(bflo(uu[k][1])) * m0[2] * silu_(bflo(gg[k][1]) + bflo(gh[k][1])), gelu_(bfhi(uu[k][1])) * m0[3] * silu_(bfhi(gg[k][1]) + bfhi(gh[k][1])));
                    o[2] = pk2(gelu_(bflo(uu[k][2])) * m1[0] * silu_(bflo(gg[k][2]) + bflo(gh[k][2])), gelu_(bfhi(uu[k][2])) * m1[1] * silu_(bfhi(gg[k][2]) + bfhi(gh[k][2])));
                    o[3] = pk2(gelu_(bflo(uu[k][3])) * m1[2] * silu_(bflo(gg[k][3]) + bflo(gh[k][3])), gelu_(bfhi(uu[k][3])) * m1[3] * silu_(bfhi(gg[k][3]) + bfhi(gh[k][3])));
                    *(u32x4*)(P.MIX + row * 1024 + 768 + 64 * hd + d0) = o;
                    asm volatile("" ::: "memory"); }
            }
        }
        __syncthreads();
    }
}

#define XB_TMO      128
#define XB_XCNT(j)  (256  + 64 * (j))
#define XB_XSUB(j)  (1280 + 64 * (j))
#define XB_XGEN(j)  (2304 + 64 * (j))
#define XB_TOP      3328
#define XB_TOPGEN   3392
#define XCD_BAR_WORDS 3456
#define XB_SPIN_CAP (1u << 18)

__device__ __forceinline__ unsigned xb_ld(unsigned* p)              { return __hip_atomic_load(p, __ATOMIC_RELAXED, __HIP_MEMORY_SCOPE_AGENT); }
__device__ __forceinline__ unsigned xb_add(unsigned* p, unsigned v) { return __hip_atomic_fetch_add(p, v, __ATOMIC_RELAXED, __HIP_MEMORY_SCOPE_AGENT); }
__device__ __forceinline__ unsigned xb_xcc_id() { return (unsigned)__builtin_amdgcn_s_getreg((3 << 11) | 20) & 0xFu; }
#define XB_SPIN(cond, bar) do { unsigned _sp = 0; while (cond) { __builtin_amdgcn_s_sleep(1); \
    if ((++_sp & 255u) == 0u) { if (xb_ld(&(bar)[XB_TMO])) break; if (_sp > XB_SPIN_CAP) { atomicAdd(&(bar)[XB_TMO], 1u); break; } } } } while (0)

struct XcdBarrier {
    unsigned* bar; unsigned x;
    volatile LAS unsigned* st;
};

__device__ __forceinline__ XcdBarrier xcd_barrier_post(unsigned* bar, volatile LAS unsigned* st) {
    XcdBarrier b; b.bar = bar; b.x = xb_xcc_id(); b.st = st;
    if (threadIdx.x == 0) (void)xb_add(&bar[XB_XCNT(b.x)], 1u);
    return b;
}
__device__ __forceinline__ void xcd_barrier_complete(unsigned* bar, unsigned x, unsigned& nloc, unsigned& nx) {
    const unsigned G = gridDim.x * gridDim.y * gridDim.z;
    unsigned sum, cnt, mine, sp = 0u;
    for (;;) {
        sum = 0u; cnt = 0u; mine = 0u;
#pragma unroll
        for (unsigned j = 0; j < 16; ++j) { const unsigned c = xb_ld(&bar[XB_XCNT(j)]); sum += c; cnt += (c > 0u) ? 1u : 0u; mine = (j == x) ? c : mine; }
        if (sum == G) break;
        __builtin_amdgcn_s_sleep(1);
        if ((++sp & 255u) == 0u) { if (xb_ld(&bar[XB_TMO])) break; if (sp > XB_SPIN_CAP) { atomicAdd(&bar[XB_TMO], 1u); break; } }
    }
    nloc = mine > 0u ? mine : 1u; nx = cnt > 0u ? cnt : 1u;
}

__device__ __forceinline__ void xcd_barrier(const XcdBarrier& b) {
    asm volatile("s_waitcnt vmcnt(0)" ::: "memory");
    __syncthreads();
    if (threadIdx.x == 0) {
        unsigned* bar = b.bar;
        __builtin_amdgcn_s_waitcnt(0);
        unsigned nloc = b.st[0], nx = b.st[1];
        if (nloc == 0u) { xcd_barrier_complete(bar, b.x, nloc, nx); b.st[0] = nloc; b.st[1] = nx; }
        const unsigned old = xb_add(&bar[XB_XSUB(b.x)], 1u);
        const unsigned gen = old / nloc;
        if (old + 1u == (gen + 1u) * nloc) {
            __builtin_amdgcn_fence(__ATOMIC_RELEASE, "agent");
            asm volatile("s_waitcnt vmcnt(0)" ::: "memory");
            const unsigned og = xb_add(&bar[XB_TOP], 1u);
            const unsigned tg = og / nx;
            if (og + 1u == (tg + 1u) * nx) xb_add(&bar[XB_TOPGEN], 1u);
            else XB_SPIN(xb_ld(&bar[XB_TOPGEN]) == tg, bar);
            __builtin_amdgcn_fence(__ATOMIC_ACQUIRE, "agent");
            xb_add(&bar[XB_XGEN(b.x)], 1u);
            asm volatile("s_waitcnt vmcnt(0)" ::: "memory");
        } else {
            XB_SPIN(xb_ld(&bar[XB_XGEN(b.x)]) == gen, bar);
            __builtin_amdgcn_fence(__ATOMIC_ACQUIRE, "agent");
            asm volatile("s_waitcnt vmcnt(0)" ::: "memory");
        }
    }
    __syncthreads();
}

struct Args { const float* in[15]; float* out; unsigned char* ws; int ph_lo, ph_hi; };
__global__ void __launch_bounds__(NWAVES * 64, 2) mega_fwd(Args args) {
    extern __shared__ __attribute__((aligned(16))) unsigned char lds[];
    LAS unsigned char* L = (LAS unsigned char*)lds;
    const int tid = threadIdx.x, lane = tid & 63, wave = __builtin_amdgcn_readfirstlane(tid >> 6);
    const int G = gridDim.x, bx = blockIdx.x, vcu = (G % 8 == 0) ? (bx % 8) * (G / 8) + bx / 8 : bx;
    const int gw = vcu * NWAVES + wave, NGW = G * NWAVES;
    unsigned char* ws = args.ws;
    const float* x = args.in[0]; const float* pre_norm = args.in[1]; const float* post_norm = args.in[2]; const float* w_in = args.in[3]; const float* w_out = args.in[4];
    bf16* WIN_T = (bf16*)(ws + WS_WIN); bf16* WOUT_T = (bf16*)(ws + WS_WOUT); bf16* XN = (bf16*)(ws + WS_XN); bf16* MIX = XN;
    bf16* Qb = (bf16*)(ws + WS_Q); bf16* KVb = (bf16*)(ws + WS_KV); bf16* Rb = (bf16*)(ws + WS_R); bf16* MO = (bf16*)(ws + WS_MO);
    f32x2* tab = (f32x2*)(ws + WS_TAB);
    float* out = args.out;
    const int lo = args.ph_lo, hi = args.ph_hi;
    volatile LAS unsigned* MISC = (volatile LAS unsigned*)(L + MISC_OFF);
    if (tid < 32) MISC[tid] = 0u;
    __syncthreads();
#if !MK_SPLIT
    if (bx == 0) { for (int w = tid; w < XCD_BAR_WORDS; w += NWAVES * 64) __hip_atomic_store((unsigned*)(ws + WS_CTL) + w, 0u, __ATOMIC_RELAXED, __HIP_MEMORY_SCOPE_AGENT); __threadfence(); }
    cg::this_grid().sync();
#endif
    XcdBarrier bar = xcd_barrier_post((unsigned*)(ws + WS_CTL), MISC + 8);
#define IN(k) (lo <= (k) && (k) < hi)
#if MK_SPLIT
#define SEAM(k) do { } while (0)
#else
#define SEAM(k) do { if (IN(k) && IN((k) + 1)) { xcd_barrier(bar); } } while (0)
#endif
    if (IN(0)) {
        LAS float* scr = (LAS float*)(L + wave * 16384);
        constexpr int I_IN = (DMODEL / 64) * (DIN / 32), I_OUT = (DMODEL / 64) * (DMODEL / 32), I_L = I_IN + I_OUT;
        for (int it = gw; it < DEPTH * I_L; it += NGW) { const int l = it / I_L, r = it - l * I_L;
            if (r < I_IN) p0_transpose_item(w_in + (size_t)l * DMODEL * DIN, DMODEL, DIN, WIN_T + (size_t)l * DIN * DMODEL, scr, r, lane);
            else p0_transpose_item(w_out + (size_t)l * DMODEL * DMODEL, DMODEL, DMODEL, WOUT_T + (size_t)l * DMODEL * DMODEL, scr, r - I_IN, lane); }
        for (int idx = bx * (NWAVES * 64) + tid; idx < 256 * 16; idx += G * NWAVES * 64) { const int pos = idx >> 4, i = idx & 15;
            const float inv = exp2f(-(float)i * (13.287712379549449f / 16.0f));
            const float ang = (float)pos * inv;
            double rev = (double)ang * 0.15915494309189535; rev -= __builtin_rint(rev);
            tab[idx] = (f32x2){__builtin_amdgcn_cosf((float)rev), __builtin_amdgcn_sinf((float)rev)}; }
        norm_phase(0, x, nullptr, nullptr, pre_norm, nullptr, XN, gw, NGW, lane);
    }
    SEAM(0);
#pragma unroll 1
    for (int l = 0; l < DEPTH; ++l) {
        const int pb = 1 + 5 * l;
        if (IN(pb)) {
            pg8::Gemm g{XN, WIN_T + (size_t)l * DIN * DMODEL, M, DIN - 256, DMODEL}; pg8::StaticOrder S; S.init(M, DIN - 256, G, bx);
            pg8::EpiProj E{Qb, KVb, Rb};
            pg8::gemm_phase<pg8::EpiProj, pg8::StaticOrder, PG8_ALIGN, PG8_SP2>(L, g, S, E);
            {
                const int pm2 = vcu >> 1, kh = vcu & 1;
                pg8::Gemm g2{XN + kh * 512, WIN_T + (size_t)l * DIN * DMODEL + (size_t)(DIN - 256) * DMODEL + kh * 512, M, 256, 512, DMODEL};
                pg8::OneUnit S2{pg8::Unit{pm2, 0}};
                pg8::EpiBf16<0> E2{(bf16*)(ws + WS_GS) + (size_t)kh * M * 256, 256, nullptr, 0, 0, 1.f};
                pg8::gemm_phase<pg8::EpiBf16<0>, pg8::OneUnit, false, PG8_SP2>(L, g2, S2, E2);
            }
#if defined(DUP_GEMM)
            if (l == 0) { __syncthreads(); pg8::gemm_phase<pg8::EpiProj, pg8::StaticOrder, PG8_ALIGN, PG8_SP2>(L, g, S, E); }
#endif
        }
        SEAM(pb);
        if (IN(pb + 1)) {
            ChunkParams P{Qb, KVb, (const bf16*)(ws + WS_GS), Rb, MIX, tab, args.in[5] + l * 64, args.in[6] + l * 64, args.in[7] + (size_t)l * 31 * 256, args.in[8] + l * 256, args.in[9] + l * 256, args.in[10] + l * 256,
                          args.in[11] + l * 256, args.in[12] + l * 256, args.in[13] + (size_t)l * 4 * 128 * 128, args.in[14] + l * 4 * 128};
            chunk_phase(L, P, vcu, G, tid);
#if defined(DUP_CHUNK)
            if (l == 1) { ChunkParams P2 = P; P2.Q = (bf16*)(ws + WS_MO); P2.KV = (bf16*)(ws + WS_MO + 40 * MiB); chunk_phase(L, P2, vcu, G, tid); }
#endif
        }
        SEAM(pb + 1);
        if (IN(pb + 2)) {
            float gq = __builtin_fabsf(args.in[5][l * 64 + lane]), gk = __builtin_fabsf(args.in[6][l * 64 + lane]);
#pragma unroll
            for (int o = 1; o < 64; o <<= 1) { gq = __builtin_fmaxf(gq, __shfl_xor(gq, o)); gk = __builtin_fmaxf(gk, __shfl_xor(gk, o)); }
            const float cshift = __builtin_fmaxf(0.f, 8.0f * 1.4426950408889634f * gq * gk - 24.0f);
            const attn_body::AttnTensors AT{(const attn_body::bf16*)Qb, (const attn_body::bf16*)KVb, (const attn_body::bf16*)(KVb + 128), (attn_body::bf16*)MIX, (const attn_body::bf16*)Rb, cshift};
            const attn_body::StaticOrder S(G, bx);
            attn_body::attn_phase<attn_body::StaticOrder>((char*)lds, AT, S);
#if defined(DUP_ATTN)
            if (l == 0) { __syncthreads(); attn_body::attn_phase<attn_body::StaticOrder>((char*)lds, AT, S); }
#endif
        }
        SEAM(pb + 2);
        if (IN(pb + 3)) {
            pg8::Gemm g{MIX, WOUT_T + (size_t)l * DMODEL * DMODEL, M, DMODEL, DMODEL}; pg8::StaticOrder S; S.init(M, DMODEL, G, bx);
            pg8::EpiBf16<0> E{MO, DMODEL, nullptr, 0, 0, 1.f};
            pg8::gemm_phase<pg8::EpiBf16<0>, pg8::StaticOrder, PG8_ALIGN, PG8_SP2>(L, g, S, E);
        }
        SEAM(pb + 3);
        if (IN(pb + 4)) {
            if (l + 1 < DEPTH) norm_phase(1, l == 0 ? x : out, MO, post_norm + l * DMODEL, pre_norm + (l + 1) * DMODEL, out, XN, gw, NGW, lane);
#if defined(DUP_NORM)
            if (l == 0) norm_phase(1, x, MO, post_norm, pre_norm + DMODEL, out, XN, gw, NGW, lane);
#endif
            else norm_phase(2, l == 0 ? x : out, MO, post_norm + l * DMODEL, nullptr, out, nullptr, gw, NGW, lane);
        }
        if (l + 1 < DEPTH) SEAM(pb + 4);
    }
#undef IN
#undef SEAM
}

extern "C" void kernel_launch(void* const* d_in, const int* in_sizes, int n_in, void* d_out, int out_size, void* d_ws, size_t ws_size, hipStream_t stream) {
    static int grid = 0;
    if (grid == 0) {
        if (n_in != 15 || in_sizes[0] != M * DMODEL || out_size != M * DMODEL || ws_size < WS_END) { fprintf(stderr, "kernel_launch: unexpected problem shape / workspace (%d inputs, ws %zu)\n", n_in, ws_size); grid = -1; return; }
        int dev = 0, cus = 0, per_cu = 0;
        if (hipGetDevice(&dev) != hipSuccess || hipDeviceGetAttribute(&cus, hipDeviceAttributeMultiprocessorCount, dev) != hipSuccess) { grid = -1; return; }
        if (hipFuncSetAttribute((const void*)mega_fwd, hipFuncAttributeMaxDynamicSharedMemorySize, LDS_BYTES) != hipSuccess) { fprintf(stderr, "kernel_launch: hipFuncSetAttribute failed\n"); grid = -1; return; }
        if (hipOccupancyMaxActiveBlocksPerMultiprocessor(&per_cu, (const void*)mega_fwd, NWAVES * 64, LDS_BYTES) != hipSuccess || per_cu < 1) { fprintf(stderr, "kernel_launch: occupancy query gave %d\n", per_cu); per_cu = 1; }
        (void)hipGetLastError();
        grid = cus * per_cu;
        if (M % (NR * grid * NWAVES) != 0) { grid = 256; }
        if (grid != 256 || grid > cus * per_cu || M % (NR * grid * NWAVES) != 0) { fprintf(stderr, "kernel_launch: unsupported device geometry (%d CUs x %d)\n", cus, per_cu); grid = -1; return; }
    }
    if (grid < 0) return;
    Args a{};
    for (int i = 0; i < 15; ++i) a.in[i] = (const float*)d_in[i];
    a.out = (float*)d_out; a.ws = (unsigned char*)d_ws;
    void* kargs[] = {&a};
#if MK_SPLIT
    for (int ph = 0; ph < NPHASE; ++ph) { a.ph_lo = ph; a.ph_hi = ph + 1;
        hipError_t e = hipLaunchCooperativeKernel((const void*)mega_fwd, dim3(grid), dim3(NWAVES * 64), kargs, LDS_BYTES, stream);
        if (e != hipSuccess) { fprintf(stderr, "kernel_launch: launch %d failed: %s\n", ph, hipGetErrorString(e)); break; } }
#else
    a.ph_lo = 0; a.ph_hi = NPHASE;
    hipError_t e = hipLaunchCooperativeKernel((const void*)mega_fwd, dim3(grid), dim3(NWAVES * 64), kargs, LDS_BYTES, stream);
    if (e != hipSuccess) fprintf(stderr, "kernel_launch: cooperative launch failed: %s (grid %d)\n", hipGetErrorString(e), grid);
#endif
}
```
